# Optimizing an MI355X kernel written in HIP

```python
import math
import jax, jax.numpy as jnp
from jax import lax
import numpy as np

D_MODEL = 1024
BATCH = 8
SEQ = 4096
DEPTH = 4

N_MIXERS = 2
N_ATTN_LAYERS = (DEPTH + 1) // 2
N_LRU_LAYERS = DEPTH // 2

D_FF = 2816

MLA_HEADS = 8
QK_NOPE_DIM = 128
QK_ROPE_DIM = 64
V_HEAD_DIM = 128
Q_LORA_RANK = 384
KV_LORA_RANK = 256
ROPE_THETA = 10000.0
Q_BLOCK = 128

LRU_WIDTH = D_MODEL
LRU_BLOCKS = 4
LRU_BLOCK_WIDTH = LRU_WIDTH // LRU_BLOCKS
CONV_WIDTH = 4
LRU_C = 8.0
LRU_MIN_RAD = 0.9
LRU_MAX_RAD = 0.999

DEEPNORM_ALPHA = (2 * DEPTH) ** 0.25
DEEPNORM_BETA = (8 * DEPTH) ** -0.25
LN_EPS = 1e-5
RMS_EPS = 1e-6

kernel_name = "bidir_mla_rglru_macaron_deepnorm"


def layer_norm(x, g, b):
    xf = x.astype(jnp.float32)
    mu = jnp.mean(xf, axis=-1, keepdims=True)
    var = jnp.mean(jnp.square(xf - mu), axis=-1, keepdims=True)
    return ((xf - mu) * lax.rsqrt(var + LN_EPS) * g + b).astype(x.dtype)


def rms_norm(x, g):
    xf = x.astype(jnp.float32)
    ms = jnp.mean(jnp.square(xf), axis=-1, keepdims=True)
    return (xf * lax.rsqrt(ms + RMS_EPS) * g).astype(x.dtype)


def swiglu(x, w1, w3, w2):
    return (jax.nn.silu(x @ w1) * (x @ w3)) @ w2


def rope_tables(positions):
    inv_freq = ROPE_THETA ** (-jnp.arange(0, QK_ROPE_DIM, 2, dtype=jnp.float32) / QK_ROPE_DIM)
    ang = positions.astype(jnp.float32)[..., None] * inv_freq
    return jnp.cos(ang), jnp.sin(ang)


def apply_rope(t, cos, sin):
    tf = t.astype(jnp.float32)
    t1, t2 = jnp.split(tf, 2, axis=-1)
    return jnp.concatenate([t1 * cos - t2 * sin, t2 * cos + t1 * sin], axis=-1).astype(t.dtype)


def mla_mixer(x, cos, sin, w_in, q_norm, kv_norm, w_uq, w_ukv, w_o):
    B, S, _ = x.shape
    h = x @ w_in
    c_q, c_kv, k_rope = jnp.split(h, [Q_LORA_RANK, Q_LORA_RANK + KV_LORA_RANK], axis=-1)
    q = (rms_norm(c_q, q_norm) @ w_uq).reshape(B, S, MLA_HEADS, QK_NOPE_DIM + QK_ROPE_DIM)
    q_nope = q[..., :QK_NOPE_DIM]
    q_rope = apply_rope(q[..., QK_NOPE_DIM:], cos[:, :, None, :], sin[:, :, None, :])
    kv = (rms_norm(c_kv, kv_norm) @ w_ukv).reshape(B, S, MLA_HEADS, QK_NOPE_DIM + V_HEAD_DIM)
    k_nope, v = kv[..., :QK_NOPE_DIM], kv[..., QK_NOPE_DIM:]
    k_rope = apply_rope(k_rope, cos, sin)
    scale = (QK_NOPE_DIM + QK_ROPE_DIM) ** -0.5
    n_blk = S // Q_BLOCK

    def to_blocks(t):
        return jnp.moveaxis(t.reshape(B, n_blk, Q_BLOCK, *t.shape[2:]), 1, 0)

    def attend(qb):
        qn, qr = qb
        s = (jnp.einsum('bqhd,bkhd->bhqk', qn, k_nope)
             + jnp.einsum('bqhr,bkr->bhqk', qr, k_rope))
        p = jax.nn.softmax(s.astype(jnp.float32) * scale, axis=-1).astype(v.dtype)
        return jnp.einsum('bhqk,bkhd->bqhd', p, v)

    o = lax.map(attend, (to_blocks(q_nope), to_blocks(q_rope)))
    o = jnp.moveaxis(o, 0, 1).reshape(B, S, MLA_HEADS * V_HEAD_DIM)
    return o @ w_o


def rg_lru_scan(xc, gate_r, gate_i, lam, reverse):
    r = jax.nn.sigmoid(gate_r)
    i = jax.nn.sigmoid(gate_i)
    log_a = LRU_C * r * jax.nn.log_sigmoid(lam.astype(jnp.float32))
    a = jnp.exp(log_a)
    u = jnp.sqrt(-jnp.expm1(2.0 * log_a)) * (i * xc)

    def combine(left, right):
        a1, b1 = left
        a2, b2 = right
        return a1 * a2, a2 * b1 + b2

    _, h = lax.associative_scan(combine, (a, u), reverse=reverse, axis=1)
    return h


def recurrent_mixer(x, w_in, conv_w, conv_b, gate_w, gate_b, lam, w_out):
    B, S, _ = x.shape
    gate, xr = jnp.split(x @ w_in, 2, axis=-1)
    pad_l = CONV_WIDTH // 2
    xc = lax.conv_general_dilated(
        xr, conv_w[:, None, :], window_strides=(1,),
        padding=[(pad_l, CONV_WIDTH - 1 - pad_l)],
        dimension_numbers=('NWC', 'WIO', 'NWC'),
        feature_group_count=LRU_WIDTH) + conv_b
    xb = xc.reshape(B, S, LRU_BLOCKS, LRU_BLOCK_WIDTH)
    g = jnp.einsum('bsnc,gncd->bsgnd', xb, gate_w).reshape(B, S, 4, LRU_WIDTH) + gate_b
    g = g.astype(jnp.float32)
    xf = xc.astype(jnp.float32)
    h = (rg_lru_scan(xf, g[:, :, 0], g[:, :, 1], lam[0], False)
         + rg_lru_scan(xf, g[:, :, 2], g[:, :, 3], lam[1], True))
    y = jax.nn.gelu(gate.astype(jnp.float32)) * h
    return y.astype(x.dtype) @ w_out


def setup_inputs(seed: int = 0) -> dict:
    key = jax.random.key(seed)
    ks = iter(jax.random.split(key, 32))

    def normal(shape, fan_in, gain=1.0):
        return jax.random.normal(next(ks), shape, jnp.float32) * (gain * fan_in ** -0.5)

    def small(shape):
        return 0.02 * jax.random.normal(next(ks), shape, jnp.float32)

    NA, NL = N_ATTN_LAYERS, N_LRU_LAYERS
    x = jax.random.normal(next(ks), (BATCH, SEQ, D_MODEL), jnp.float32)
    offsets = jax.random.randint(next(ks), (BATCH, 1), 0, SEQ, dtype=jnp.int32)
    positions = offsets + jnp.arange(SEQ, dtype=jnp.int32)[None, :]
    ln_g = 1.0 + small((DEPTH, 3, D_MODEL))
    ln_b = small((DEPTH, 3, D_MODEL))
    ffn_w1 = normal((DEPTH, 2, D_MODEL, D_FF), D_MODEL)
    ffn_w3 = normal((DEPTH, 2, D_MODEL, D_FF), D_MODEL)
    ffn_w2 = normal((DEPTH, 2, D_FF, D_MODEL), D_FF, DEEPNORM_BETA)
    mla_w_in = normal((NA, D_MODEL, Q_LORA_RANK + KV_LORA_RANK + QK_ROPE_DIM), D_MODEL)
    mla_q_norm = 1.0 + small((NA, Q_LORA_RANK))
    mla_kv_norm = 1.0 + small((NA, KV_LORA_RANK))
    mla_w_uq = normal((NA, Q_LORA_RANK, MLA_HEADS * (QK_NOPE_DIM + QK_ROPE_DIM)), Q_LORA_RANK)
    mla_w_ukv = normal((NA, KV_LORA_RANK, MLA_HEADS * (QK_NOPE_DIM + V_HEAD_DIM)), KV_LORA_RANK)
    mla_w_o = normal((NA, MLA_HEADS * V_HEAD_DIM, D_MODEL), MLA_HEADS * V_HEAD_DIM, DEEPNORM_BETA)
    lru_w_in = normal((NL, D_MODEL, 2 * LRU_WIDTH), D_MODEL)
    lru_conv_w = normal((NL, CONV_WIDTH, LRU_WIDTH), CONV_WIDTH)
    lru_conv_b = small((NL, LRU_WIDTH))
    lru_gate_w = normal((NL, 4, LRU_BLOCKS, LRU_BLOCK_WIDTH, LRU_BLOCK_WIDTH), LRU_BLOCK_WIDTH)
    lru_gate_b = small((NL, 4, LRU_WIDTH))
    u = jax.random.uniform(next(ks), (NL, 2, LRU_WIDTH), jnp.float32,
                           minval=LRU_MIN_RAD ** 2, maxval=LRU_MAX_RAD ** 2)
    s = jnp.sqrt(u)
    lru_lambda = jnp.log(s) - jnp.log1p(-s)
    lru_w_out = normal((NL, LRU_WIDTH, D_MODEL), LRU_WIDTH, DEEPNORM_BETA)
    return {"x": x, "positions": positions, "ln_g": ln_g, "ln_b": ln_b,
            "ffn_w1": ffn_w1, "ffn_w3": ffn_w3, "ffn_w2": ffn_w2,
            "mla_w_in": mla_w_in, "mla_q_norm": mla_q_norm, "mla_kv_norm": mla_kv_norm,
            "mla_w_uq": mla_w_uq, "mla_w_ukv": mla_w_ukv, "mla_w_o": mla_w_o,
            "lru_w_in": lru_w_in, "lru_conv_w": lru_conv_w, "lru_conv_b": lru_conv_b,
            "lru_gate_w": lru_gate_w, "lru_gate_b": lru_gate_b, "lru_lambda": lru_lambda,
            "lru_w_out": lru_w_out}


def reference(x, positions, ln_g, ln_b, ffn_w1, ffn_w3, ffn_w2,
              mla_w_in, mla_q_norm, mla_kv_norm, mla_w_uq, mla_w_ukv, mla_w_o,
              lru_w_in, lru_conv_w, lru_conv_b, lru_gate_w, lru_gate_b, lru_lambda,
              lru_w_out):
    cos, sin = rope_tables(positions)

    def post_norm(x, y, i, j):
        return layer_norm(DEEPNORM_ALPHA * x + y, ln_g[i, j], ln_b[i, j])

    for i in range(DEPTH):
        x = post_norm(x, 0.5 * swiglu(x, ffn_w1[i, 0], ffn_w3[i, 0], ffn_w2[i, 0]), i, 0)
        k = i // N_MIXERS
        if i % N_MIXERS == 0:
            y = mla_mixer(x, cos, sin, mla_w_in[k], mla_q_norm[k], mla_kv_norm[k],
                          mla_w_uq[k], mla_w_ukv[k], mla_w_o[k])
        else:
            y = recurrent_mixer(x, lru_w_in[k], lru_conv_w[k], lru_conv_b[k],
                                lru_gate_w[k], lru_gate_b[k], lru_lambda[k], lru_w_out[k])
        x = post_norm(x, y, i, 1)
        x = post_norm(x, 0.5 * swiglu(x, ffn_w1[i, 1], ffn_w3[i, 1], ffn_w2[i, 1]), i, 2)
    return x
```

```cpp
#include <hip/hip_runtime.h>
#include <hip/hip_cooperative_groups.h>
#include <cstdio>
#include <cstdint>
namespace cg = cooperative_groups;

#ifndef MK_PER_PHASE
#define MK_PER_PHASE 0
#endif

#define LAS __attribute__((address_space(3)))
typedef unsigned short bf16;
typedef short bf16x8 __attribute__((ext_vector_type(8)));
typedef short s16x4 __attribute__((ext_vector_type(4)));
typedef float f32x4 __attribute__((ext_vector_type(4)));
typedef float f32x2 __attribute__((ext_vector_type(2)));
typedef float f32x16 __attribute__((ext_vector_type(16)));
typedef unsigned u32x4 __attribute__((ext_vector_type(4)));
typedef unsigned u32x2 __attribute__((ext_vector_type(2)));

constexpr int BATCH = 8, SEQ = 4096, DM = 1024, M = BATCH * SEQ, DFF = 2816, DEPTH = 4;
constexpr int HEADS = 8, QLR = 384, KVLR = 256;
constexpr float ALPHA = 1.681792830507429f;
constexpr float LN_EPS = 1e-5f, RMS_EPS = 1e-6f;
constexpr float QSCALE = 0.10411754627697264f;
constexpr float THR2 = 11.541560327111707f;
constexpr float LOG2E = 1.4426950408889634f;

constexpr size_t MiB = 1u << 20;
constexpr size_t WS_W = 1 * MiB;
constexpr size_t W_FFN = 16 * MiB + MiB / 2;
constexpr size_t W_W2T = 11 * MiB;
constexpr size_t W_MIX = 33 * MiB;
constexpr size_t W_MLA_IN = 0, W_MLA_UQ = MiB + MiB / 2, W_MLA_UKV = W_MLA_UQ + MiB + MiB / 8, W_MLA_O = W_MLA_UKV + MiB;
constexpr size_t W_LRU_IN = 0, W_LRU_GATE = 4 * MiB, W_LRU_OUT = 6 * MiB;
constexpr size_t WS_R0 = 44 * MiB;
constexpr size_t WS_T = 108 * MiB;
constexpr size_t T_H = 0;
constexpr size_t T_HMLA = 0, T_QN = 0, T_QR = 64 * MiB, T_CQN = 96 * MiB, T_CKVN = 120 * MiB, T_KN = 136 * MiB, T_KR = 200 * MiB, T_V = 204 * MiB;
constexpr size_t T_GG = 0, T_P = 64 * MiB, T_XR = 64 * MiB, T_AGG = 320 * MiB;
constexpr size_t WS_END = WS_T + 332 * MiB;
constexpr int N_PHASES = 40;
#ifndef PROBE
#define PROBE 0
#endif

typedef __bf16 bf16x2_t __attribute__((ext_vector_type(2)));
__device__ __forceinline__ unsigned cvt_pk_bf16(float lo, float hi) { const f32x2 v = {lo, hi}; const bf16x2_t b = __builtin_convertvector(v, bf16x2_t); return __builtin_bit_cast(unsigned, b); }
typedef _Float16 h16x2 __attribute__((ext_vector_type(2)));
typedef _Float16 f16x8 __attribute__((ext_vector_type(8)));
__device__ __forceinline__ unsigned pk_f16(float a, float b) { h16x2 v = {(_Float16)a, (_Float16)b}; return __builtin_bit_cast(unsigned, v); }
__device__ __forceinline__ float f16_lo(unsigned w) { const h16x2 v = __builtin_bit_cast(h16x2, w); return (float)v[0]; }
__device__ __forceinline__ float f16_hi(unsigned w) { const h16x2 v = __builtin_bit_cast(h16x2, w); return (float)v[1]; }
__device__ __forceinline__ float bf_lo(unsigned w) { return __uint_as_float(w << 16); }
__device__ __forceinline__ float bf_hi(unsigned w) { return __uint_as_float(w & 0xffff0000u); }
__device__ __forceinline__ float fast_sigmoid(float x) { return __builtin_amdgcn_rcpf(1.0f + __builtin_amdgcn_exp2f(-x * LOG2E)); }
__device__ __forceinline__ float silu_f(float x) { return x * fast_sigmoid(x); }
__device__ __forceinline__ float gelu_tanh_f(float x) { const float z = 0.7978845608028654f * (x + 0.044715f * x * x * x); return x * fast_sigmoid(2.0f * z); }
__device__ __forceinline__ float wave_sum(float v) {
#pragma unroll
    for (int o = 1; o < 64; o <<= 1) v += __shfl_xor(v, o);
    return v;
}
__device__ const double INV_REV[32] = {0.15915494309189535, 0.11934937021124886, 0.08949940160889101, 0.06711508300522726, 0.050329212104487035, 0.03774158471741977, 0.0283021958306234, 0.02122365276477766,
    0.015915494309189534, 0.011934937021124886, 0.008949940160889102, 0.006711508300522725, 0.005032921210448704, 0.003774158471741977, 0.00283021958306234, 0.0021223652764777662,
    0.0015915494309189536, 0.0011934937021124885, 0.0008949940160889102, 0.0006711508300522726, 0.0005032921210448703, 0.00037741584717419774, 0.00028302195830623395, 0.0002122365276477766,
    0.00015915494309189535, 0.00011934937021124886, 8.949940160889102e-05, 6.711508300522725e-05, 5.0329212104487035e-05, 3.774158471741978e-05, 2.8302195830623396e-05, 2.122365276477766e-05};
__device__ __forceinline__ void rope_cs(int pos, int j, float& c, float& s) {
    double rev = (double)pos * INV_REV[j];
    rev -= (double)(long long)rev;
    const float f = (float)rev;
    c = __builtin_amdgcn_cosf(f); s = __builtin_amdgcn_sinf(f);
}

namespace pg8 {
constexpr int BM = 256, BK = 64, HALF = 128, HTB = HALF * BK * 2, STAGE_BYTES = 8 * HTB, NXCD = 8, WGM = 8;
__host__ __device__ __forceinline__ int lds_byte(int r, int c) { const int st = (r >> 4) * 2 + (c >> 5), rr = r & 15, cc = c & 31, ob = rr * 64 + cc * 2; return st * 1024 + (ob ^ (((ob >> 9) & 1) << 5)); }
__host__ __device__ __forceinline__ void stage_rc(int b, int& R, int& C) { const int st = b / 1024, sb = b % 1024, swz = sb ^ (((sb >> 9) & 1) << 5); R = (st >> 1) * 16 + swz / 64; C = (st & 1) * 32 + (swz % 64) / 2; }
__host__ __device__ __forceinline__ int perm32(int rho) { const int n = rho >> 4, i = rho & 15; return 8 * (i >> 2) + 4 * n + (i & 3); }

struct Unit { int pm, pn; };
struct Gemm { const bf16* A; const bf16* Bt; int lda, ldb, K; int a_sh, a_mask, a_cols; };

struct StaticOrder {
    int nM, nN, nwg, G, c;
    __device__ void init(int M_, int N_, int G_, int c_) { nM = M_ / BM; nN = N_ / BM; nwg = nM * nN; G = G_; c = c_; }
    __device__ bool next(int i, Unit& u) const {
        const long L = (long)i * G + c; if (L >= nwg) return false;
        int wgid = (int)L; { const int q = nwg / NXCD, r = nwg % NXCD, xcd = wgid % NXCD, off = wgid / NXCD; wgid = (xcd < r ? xcd * (q + 1) : r * (q + 1) + (xcd - r) * q) + off; }
        const int nig = WGM * nN, gid = wgid / nig, fm = gid * WGM, gsz = (nM - fm) < WGM ? (nM - fm) : WGM;
        u.pm = fm + ((wgid % nig) % gsz); u.pn = (wgid % nig) / gsz; return true;
    }
};

typedef f32x4 Acc[2][2][4][2];

struct EpiSwiglu {
    static constexpr bool PERM = true, FUSED = false, F16 = true;
    bf16* H; int ldh;
    __device__ __forceinline__ void operator()(const Acc& acc, const Unit& u, int wr, int wc, int fr, int fq) const {
        const int row0 = u.pm * BM + wr * 64 + fr, col = u.pn * 128 + wc * 32 + 8 * fq;
#pragma unroll
        for (int ai = 0; ai < 2; ++ai)
#pragma unroll
            for (int m = 0; m < 4; ++m) {
                bf16* p = H + (size_t)(row0 + ai * HALF + m * 16) * ldh + col;
                const f32x4 g0 = acc[ai][0][m][0], g1 = acc[ai][0][m][1], u0 = acc[ai][1][m][0], u1 = acc[ai][1][m][1];
                u32x4 w;
                w.x = cvt_pk_bf16(silu_f(g0[0]) * u0[0], silu_f(g0[1]) * u0[1]); w.y = cvt_pk_bf16(silu_f(g0[2]) * u0[2], silu_f(g0[3]) * u0[3]);
                w.z = cvt_pk_bf16(silu_f(g1[0]) * u1[0], silu_f(g1[1]) * u1[1]); w.w = cvt_pk_bf16(silu_f(g1[2]) * u1[2], silu_f(g1[3]) * u1[3]);
                *(u32x4*)p = w;
            }
    }
};
struct EpiResid {
    static constexpr bool PERM = true, FUSED = true, F16 = false;
    bf16* XN; float* Y; int wr_f32; float alpha, s; const float* lg; const float* lb;
    unsigned long long* xslots;
    unsigned tag;
    unsigned* tmo;
    __device__ __forceinline__ void fused(Acc& acc, const Unit& u, int wr, int wc, int fr, int fq, LAS unsigned char* lds, int wid, int lane) const {
        LAS f32x2* P = (LAS f32x2*)lds;
        LAS f32x2* S = (LAS f32x2*)(lds + 8192);
        const int col0 = u.pn * BM + wc * 32 + 8 * fq;
#pragma unroll
        for (int ai = 0; ai < 2; ++ai) {
#pragma unroll
            for (int m = 0; m < 4; ++m) { const size_t off = (size_t)(u.pm * BM + ai * HALF + wr * 64 + m * 16 + fr) * DM + col0;
#pragma unroll
                for (int bj = 0; bj < 2; ++bj) { const u32x4 hx = *(const u32x4*)(XN + off + bj * HALF);
                    const f32x4 x0 = {f16_lo(hx.x), f16_hi(hx.x), f16_lo(hx.y), f16_hi(hx.y)}, x1 = {f16_lo(hx.z), f16_hi(hx.z), f16_lo(hx.w), f16_hi(hx.w)};
                    acc[ai][bj][m][0] = x0 * alpha + acc[ai][bj][m][0] * s; acc[ai][bj][m][1] = x1 * alpha + acc[ai][bj][m][1] * s; }
                asm volatile("" : "+v"(acc[ai][0][m][0]), "+v"(acc[ai][0][m][1]), "+v"(acc[ai][1][m][0]), "+v"(acc[ai][1][m][1])); }
            asm volatile("" ::: "memory");
        }
        f32x4 gv[2][2], bv[2][2];
#pragma unroll
        for (int bj = 0; bj < 2; ++bj)
#pragma unroll
            for (int n = 0; n < 2; ++n) { gv[bj][n] = *(const f32x4*)(lg + col0 + bj * HALF + n * 4); bv[bj][n] = *(const f32x4*)(lb + col0 + bj * HALF + n * 4); }
#pragma unroll
        for (int ai = 0; ai < 2; ++ai)
#pragma unroll
            for (int m = 0; m < 4; ++m) {
                float sm = 0.f;
#pragma unroll
                for (int bj = 0; bj < 2; ++bj)
#pragma unroll
                    for (int n = 0; n < 2; ++n) { const f32x4 x = acc[ai][bj][m][n]; sm += (x[0] + x[1]) + (x[2] + x[3]); }
                sm += __shfl_xor(sm, 16); sm += __shfl_xor(sm, 32);
                const float mw = sm * (1.0f / 64.0f); float q = 0.f;
#pragma unroll
                for (int bj = 0; bj < 2; ++bj)
#pragma unroll
                    for (int n = 0; n < 2; ++n) { const f32x4 d = acc[ai][bj][m][n] - mw; q += (d[0] * d[0] + d[1] * d[1]) + (d[2] * d[2] + d[3] * d[3]); }
                q += __shfl_xor(q, 16); q += __shfl_xor(q, 32);
                if (fq == 0) P[(ai * HALF + wr * 64 + m * 16 + fr) * 4 + wc] = (f32x2){mw, q};
            }
        asm volatile("s_waitcnt lgkmcnt(0)" ::: "memory"); __builtin_amdgcn_s_barrier(); asm volatile("" ::: "memory");
        const int row = wid * 32 + (lane & 31);
        bool bad = false;
        if (lane < 32) {
            const f32x2 a = P[row * 4 + 0], b = P[row * 4 + 1], c = P[row * 4 + 2], d = P[row * 4 + 3];
            const float mt = (a.x + b.x + c.x + d.x) * 0.25f;
            const float da = a.x - mt, db = b.x - mt, dc = c.x - mt, dd = d.x - mt;
            const float m2 = (a.y + b.y) + (c.y + d.y) + 64.0f * ((da * da + db * db) + (dc * dc + dd * dd));
            unsigned long long* slot = xslots + (size_t)(u.pm * BM + row) * 4;
            const unsigned long long mine = ((unsigned long long)((__float_as_uint(m2) & ~31u) | tag) << 32) | __float_as_uint(mt);
            __hip_atomic_store(slot + u.pn, mine, __ATOMIC_RELAXED, __HIP_MEMORY_SCOPE_AGENT);
            unsigned long long w[4]; unsigned spins = 0;
            for (;;) {
                bool ok = true;
#pragma unroll
                for (int t = 0; t < 4; ++t) { w[t] = (t == u.pn) ? mine : __hip_atomic_load(slot + t, __ATOMIC_RELAXED, __HIP_MEMORY_SCOPE_AGENT); ok = ok && (((unsigned)(w[t] >> 32) & 31u) == tag); }
                if (ok) break;
                if (++spins > (1u << 20)) { __hip_atomic_store(tmo, 1u, __ATOMIC_RELAXED, __HIP_MEMORY_SCOPE_AGENT); bad = true; break; }
            }
            float mtv[4], m2v[4]; float ms = 0.f;
#pragma unroll
            for (int t = 0; t < 4; ++t) { mtv[t] = __uint_as_float((unsigned)w[t]); m2v[t] = __uint_as_float((unsigned)(w[t] >> 32) & ~31u); ms += mtv[t]; }
            const float mean = ms * 0.25f; float q = 0.f;
#pragma unroll
            for (int t = 0; t < 4; ++t) { const float dm = mtv[t] - mean; q += m2v[t] + 256.0f * dm * dm; }
            S[row] = (f32x2){mean, bad ? __builtin_nanf("") : 1.0f / sqrtf(q * (1.0f / 1024.0f) + LN_EPS)};
        }
        asm volatile("s_waitcnt vmcnt(0) lgkmcnt(0)" ::: "memory"); __builtin_amdgcn_s_barrier(); asm volatile("" ::: "memory");
#pragma unroll
        for (int ai = 0; ai < 2; ++ai)
#pragma unroll
            for (int m = 0; m < 4; ++m) { const int r = ai * HALF + wr * 64 + m * 16 + fr; const f32x2 sr = S[r]; const size_t off = (size_t)(u.pm * BM + r) * DM + col0;
#pragma unroll
                for (int bj = 0; bj < 2; ++bj) {
                    f32x4 o0 = (acc[ai][bj][m][0] - sr.x) * sr.y * gv[bj][0] + bv[bj][0], o1 = (acc[ai][bj][m][1] - sr.x) * sr.y * gv[bj][1] + bv[bj][1];
                    *(u32x4*)(XN + off + bj * HALF) = (u32x4){pk_f16(o0[0], o0[1]), pk_f16(o0[2], o0[3]), pk_f16(o1[0], o1[1]), pk_f16(o1[2], o1[3])};
                    if (wr_f32) { *(f32x4*)(Y + off + bj * HALF) = o0; *(f32x4*)(Y + off + bj * HALF + 4) = o1; } } }
    }
};
__device__ __forceinline__ u32x4 pack8(const f32x4 a, const f32x4 b) { u32x4 w; w.x = cvt_pk_bf16(a[0], a[1]); w.y = cvt_pk_bf16(a[2], a[3]); w.z = cvt_pk_bf16(b[0], b[1]); w.w = cvt_pk_bf16(b[2], b[3]); return w; }
struct EpiMlaIn {
    static constexpr bool PERM = true, FUSED = false, F16 = true;
    bf16* CQ; bf16* CKV; bf16* KR; float* stat; const int* pos;
    __device__ __forceinline__ void operator()(const Acc& acc, const Unit& u, int wr, int wc, int fr, int fq) const {
        const int row0 = u.pm * BM + wr * 64 + fr, lc = wc * 32 + 8 * fq;
#pragma unroll
        for (int ai = 0; ai < 2; ++ai)
#pragma unroll
            for (int m = 0; m < 4; ++m) { const int row = row0 + ai * HALF + m * 16;
#pragma unroll
                for (int bj = 0; bj < 2; ++bj) { const int seg = u.pn * 2 + bj; const f32x4 v0 = acc[ai][bj][m][0], v1 = acc[ai][bj][m][1];
                    if (seg < 5) {
                        float ss = (v0[0] * v0[0] + v0[1] * v0[1]) + (v0[2] * v0[2] + v0[3] * v0[3]) + (v1[0] * v1[0] + v1[1] * v1[1]) + (v1[2] * v1[2] + v1[3] * v1[3]);
                        ss += __shfl_xor(ss, 16); ss += __shfl_xor(ss, 32);
                        if (fq == 0) atomicAdd(stat + (size_t)row * 2 + (seg >= 3 ? 1 : 0), ss);
                        bf16* dst = (seg < 3) ? CQ + (size_t)row * QLR + seg * 128 + lc : CKV + (size_t)row * KVLR + (seg - 3) * 128 + lc;
                        *(u32x4*)dst = pack8(v0, v1);
                    } else if (wc < 2) {
                        const int jj0 = 16 * wc + 4 * fq; const int ps = pos[row]; f32x4 o1, o2;
#pragma unroll
                        for (int e = 0; e < 4; ++e) { float c, sn; rope_cs(ps, jj0 + e, c, sn); o1[e] = v0[e] * c - v1[e] * sn; o2[e] = v1[e] * c + v0[e] * sn; }
                        *(u32x2*)(KR + (size_t)row * 64 + jj0) = (u32x2){cvt_pk_bf16(o1[0], o1[1]), cvt_pk_bf16(o1[2], o1[3])};
                        *(u32x2*)(KR + (size_t)row * 64 + 32 + jj0) = (u32x2){cvt_pk_bf16(o2[0], o2[1]), cvt_pk_bf16(o2[2], o2[3])};
                    } } }
    }
};
struct EpiQ {
    static constexpr bool PERM = true, FUSED = false, F16 = false;
    bf16* Qn; bf16* Qr; const int* pos; const float* stat;
    __device__ __forceinline__ void operator()(const Acc& acc, const Unit& u, int wr, int wc, int fr, int fq) const {
        const int row0 = u.pm * BM + wr * 64 + fr;
        if (u.pn < 4) {
            const int col = u.pn * BM + wc * 32 + 8 * fq;
#pragma unroll
            for (int ai = 0; ai < 2; ++ai)
#pragma unroll
                for (int m = 0; m < 4; ++m) { const int row = row0 + ai * HALF + m * 16; bf16* p = Qn + (size_t)row * DM + col;
                    const float sc = QSCALE / sqrtf(stat[(size_t)row * 2] * (1.f / QLR) + RMS_EPS);
#pragma unroll
                    for (int bj = 0; bj < 2; ++bj) *(u32x4*)(p + bj * HALF) = pack8(acc[ai][bj][m][0] * sc, acc[ai][bj][m][1] * sc); }
        } else {
            const int head = 4 * (u.pn - 4) + wc, j0 = 8 * fq;
#pragma unroll
            for (int ai = 0; ai < 2; ++ai)
#pragma unroll
                for (int m = 0; m < 4; ++m) {
                    const int row = row0 + ai * HALF + m * 16; const int ps = pos[row];
                    const float sc = QSCALE / sqrtf(stat[(size_t)row * 2] * (1.f / QLR) + RMS_EPS);
                    f32x4 o1[2], o2[2];
#pragma unroll
                    for (int n = 0; n < 2; ++n)
#pragma unroll
                        for (int e = 0; e < 4; ++e) { float c, s; rope_cs(ps, j0 + 4 * n + e, c, s); const float t1 = acc[ai][0][m][n][e], t2 = acc[ai][1][m][n][e];
                            o1[n][e] = (t1 * c - t2 * s) * sc; o2[n][e] = (t2 * c + t1 * s) * sc; }
                    bf16* p = Qr + (size_t)row * 512 + head * 64 + j0;
                    *(u32x4*)p = pack8(o1[0], o1[1]); *(u32x4*)(p + 32) = pack8(o2[0], o2[1]);
                }
        }
    }
};
struct EpiKV {
    static constexpr bool PERM = true, FUSED = false, F16 = false;
    bf16* Kn; bf16* V; const float* stat;
    __device__ __forceinline__ void operator()(const Acc& acc, const Unit& u, int wr, int wc, int fr, int fq) const {
        const int row0 = u.pm * BM + wr * 64 + fr, col = u.pn * 128 + wc * 32 + 8 * fq;
#pragma unroll
        for (int ai = 0; ai < 2; ++ai)
#pragma unroll
            for (int m = 0; m < 4; ++m) { const int row = row0 + ai * HALF + m * 16; const size_t off = (size_t)row * DM + col;
                const float sc = 1.0f / sqrtf(stat[(size_t)row * 2 + 1] * (1.f / KVLR) + RMS_EPS);
                *(u32x4*)(Kn + off) = pack8(acc[ai][0][m][0] * sc, acc[ai][0][m][1] * sc); *(u32x4*)(V + off) = pack8(acc[ai][1][m][0] * sc, acc[ai][1][m][1] * sc); }
    }
};
struct EpiLruIn {
    static constexpr bool PERM = true, FUSED = false, F16 = true;
    bf16* GG; bf16* XR;
    __device__ __forceinline__ void operator()(const Acc& acc, const Unit& u, int wr, int wc, int fr, int fq) const {
        const int row0 = u.pm * BM + wr * 64 + fr; const bool isg = u.pn < 4; const int col = (u.pn & 3) * BM + wc * 32 + 8 * fq; bf16* base = isg ? GG : XR;
#pragma unroll
        for (int ai = 0; ai < 2; ++ai)
#pragma unroll
            for (int m = 0; m < 4; ++m) { bf16* p = base + (size_t)(row0 + ai * HALF + m * 16) * DM + col;
#pragma unroll
                for (int bj = 0; bj < 2; ++bj) { f32x4 a = acc[ai][bj][m][0], b = acc[ai][bj][m][1];
                    if (isg) {
#pragma unroll
                        for (int e = 0; e < 4; ++e) { a[e] = gelu_tanh_f(a[e]); b[e] = gelu_tanh_f(b[e]); } }
                    *(u32x4*)(p + bj * HALF) = pack8(a, b); } }
    }
};
struct EpiGate {
    static constexpr bool PERM = true, FUSED = false, F16 = false;
    unsigned* P; const bf16* XC; const float* gate_b; const float* lam;
    __device__ __forceinline__ void operator()(const Acc& acc, const Unit& u, int wr, int wc, int fr, int fq) const {
        const int dir = u.pn >> 3, nb = (u.pn >> 1) & 3, hd = u.pn & 1;
        const int row0 = u.pm * BM + wr * 64 + fr, ch0 = nb * 256 + hd * 128 + wc * 32 + 8 * fq;
        float br[8], bi[8], ls[8];
#pragma unroll
        for (int e = 0; e < 8; ++e) { br[e] = gate_b[(2 * dir) * DM + ch0 + e]; bi[e] = gate_b[(2 * dir + 1) * DM + ch0 + e];
            ls[e] = lam[dir * DM + ch0 + e]; }
        unsigned* Pd = P + (size_t)dir * M * DM;
#pragma unroll
        for (int ai = 0; ai < 2; ++ai)
#pragma unroll
            for (int m = 0; m < 4; ++m) {
                const size_t off = (size_t)(row0 + ai * HALF + m * 16) * DM + ch0;
                const u32x4 xw = *(const u32x4*)(XC + off);
                unsigned w[8];
#pragma unroll
                for (int e = 0; e < 8; ++e) {
                    const float r = fast_sigmoid(acc[ai][0][m][e >> 2][e & 3] + br[e]), ig = fast_sigmoid(acc[ai][1][m][e >> 2][e & 3] + bi[e]);
                    const unsigned xww = xw[e >> 1]; const float xc = (e & 1) ? bf_hi(xww) : bf_lo(xww);
                    const float la2 = r * ls[e]; const float a2 = __builtin_amdgcn_exp2f(2.0f * la2);
                    const float uu = __builtin_amdgcn_sqrtf(fmaxf(1.0f - a2, 0.0f)) * ig * xc;
                    w[e] = cvt_pk_bf16(la2, uu);
                }
                *(u32x4*)(Pd + off) = (u32x4){w[0], w[1], w[2], w[3]}; *(u32x4*)(Pd + off + 4) = (u32x4){w[4], w[5], w[6], w[7]};
            }
    }
};

template <class Epi>
__device__ __forceinline__ void gemm_phase(LAS unsigned char* lds, const Gemm g, const StaticOrder& S, const Epi& E) {
    int tid_ = threadIdx.x; asm volatile("" : "+v"(tid_));
    const int tid = tid_, wid = __builtin_amdgcn_readfirstlane(tid >> 6), lane = tid & 63, wr = wid >> 2, wc = wid & 3, fr = lane & 15, fq = lane >> 4;
    int K_ = g.K; asm volatile("" : "+s"(K_));
    const int K = K_, nt = K / BK;
    unsigned voffA[2], voffB[2];
#pragma unroll
    for (int i = 0; i < 2; ++i) { int R, C; stage_rc(tid * 16 + i * 8192, R, C); const int Rb = Epi::PERM ? ((R & ~31) + perm32(R & 31)) : R;
        voffA[i] = (unsigned)(R * g.lda + C) * 2u; voffB[i] = (unsigned)(Rb * g.ldb + C) * 2u; }
    const size_t kstep = (size_t)(BK * 2);
    const size_t hstepA = (size_t)HALF * g.lda * 2, hstepB = (size_t)HALF * g.ldb * 2;
    const unsigned ldsw = (unsigned)wid * 1024u;
    const int aoff = lds_byte(wr * 64 + fr, fq * 8), boff = lds_byte(wc * 32 + fr, fq * 8);
#define PG8_UA(u) ((const char*)g.A + (size_t)(u).pm * 2 * hstepA + (size_t)((((u).pn >> g.a_sh) & g.a_mask) * g.a_cols) * 2)
#define PG8_UB(u) ((const char*)g.Bt + (size_t)(u).pn * 2 * hstepB)
#define PG8_SA(b, h) (((b) * 2 + (h)) * HTB)
#define PG8_SB(b, h) ((4 + (b) * 2 + (h)) * HTB)
#define PG8_STAGE(bufoff, gbase, voff) do { _Pragma("unroll") for (int _i = 0; _i < 2; ++_i) \
        __builtin_amdgcn_global_load_lds((const unsigned*)((const char*)(gbase) + (voff)[_i]), (LAS unsigned*)(lds + (bufoff) + ldsw + _i * 8192), 16, 0, 0); } while (0)
#define PG8_LDA(dst, b, h) do { _Pragma("unroll") for (int m = 0; m < 4; ++m) _Pragma("unroll") for (int k = 0; k < 2; ++k) dst[m][k] = *(const LAS bf16x8*)(lds + PG8_SA(b, h) + aoff + m * 2048 + k * 1024); } while (0)
#define PG8_LDB(dst, b, h) do { _Pragma("unroll") for (int n = 0; n < 2; ++n) _Pragma("unroll") for (int k = 0; k < 2; ++k) dst[n][k] = *(const LAS bf16x8*)(lds + PG8_SB(b, h) + boff + n * 2048 + k * 1024); } while (0)
#define PG8_MMA(ai, bj, At, Bt) do { __builtin_amdgcn_s_setprio(1); _Pragma("unroll") for (int m = 0; m < 4; ++m) _Pragma("unroll") for (int n = 0; n < 2; ++n) _Pragma("unroll") for (int k = 0; k < 2; ++k) \
        { if constexpr (Epi::F16) acc[ai][bj][m][n] = __builtin_amdgcn_mfma_f32_16x16x32_f16(__builtin_bit_cast(f16x8, Bt[n][k]), __builtin_bit_cast(f16x8, At[m][k]), acc[ai][bj][m][n], 0, 0, 0); \
          else acc[ai][bj][m][n] = __builtin_amdgcn_mfma_f32_16x16x32_bf16(Bt[n][k], At[m][k], acc[ai][bj][m][n], 0, 0, 0); } __builtin_amdgcn_s_setprio(0); } while (0)
#define PG8_WAIT_V(n) asm volatile("s_waitcnt vmcnt(" #n ")" ::: "memory")
#define PG8_WAIT_L(n) asm volatile("s_waitcnt lgkmcnt(" #n ")" ::: "memory")
#define PG8_BAR __builtin_amdgcn_s_barrier()
#define PG8_SCHED __builtin_amdgcn_sched_barrier(0)
    Unit cur, nxt; int ui = 0;
    if (!S.next(0, cur)) return;
    Acc acc;
#pragma unroll
    for (int a = 0; a < 2; ++a)
#pragma unroll
        for (int b = 0; b < 2; ++b)
#pragma unroll
            for (int m = 0; m < 4; ++m)
#pragma unroll
                for (int n = 0; n < 2; ++n) acc[a][b][m][n] = (f32x4){0.f, 0.f, 0.f, 0.f};
    bf16x8 At[4][2], B0[2][2], B1[2][2];
    const char* cA = PG8_UA(cur); const char* cB = PG8_UB(cur);
    PG8_STAGE(PG8_SB(0, 0), cB, voffB); PG8_STAGE(PG8_SB(0, 1), cB + hstepB, voffB); PG8_STAGE(PG8_SA(0, 0), cA, voffA); PG8_STAGE(PG8_SA(0, 1), cA + hstepA, voffA);
    PG8_STAGE(PG8_SB(1, 0), cB + kstep, voffB); PG8_STAGE(PG8_SA(1, 0), cA + kstep, voffA); PG8_STAGE(PG8_SB(1, 1), cB + hstepB + kstep, voffB);
    if (wr == 1) PG8_BAR;
    PG8_WAIT_V(8); PG8_BAR;
    PG8_WAIT_V(6); PG8_BAR;
    for (;;) {
        const bool has_next = S.next(ui + 1, nxt);
        const char* nA = has_next ? PG8_UA(nxt) : cA; const char* nB = has_next ? PG8_UB(nxt) : cB;
        for (int t = 0; t < nt; t += 2) {
            const bool last = (t == nt - 2);
            const char* a1 = cA + (size_t)(t + 1) * kstep;
            const char* a2 = last ? nA : cA + (size_t)(t + 2) * kstep; const char* b2 = last ? nB : cB + (size_t)(t + 2) * kstep;
            const char* a3 = a2 + kstep; const char* b3 = b2 + kstep;
            PG8_LDB(B0, 0, 0); PG8_LDB(B1, 0, 1); PG8_SCHED; PG8_LDA(At, 0, 0); PG8_STAGE(PG8_SA(1, 1), a1 + hstepA, voffA);
            PG8_WAIT_V(8); PG8_WAIT_L(0); PG8_BAR; PG8_MMA(0, 0, At, B0); PG8_MMA(0, 1, At, B1); PG8_BAR; PG8_SCHED;
            PG8_LDA(At, 0, 1); PG8_STAGE(PG8_SB(0, 0), b2, voffB); PG8_STAGE(PG8_SB(0, 1), b2 + hstepB, voffB); PG8_STAGE(PG8_SA(0, 0), a2, voffA);
            PG8_WAIT_V(8); PG8_WAIT_L(0); PG8_BAR; PG8_MMA(1, 0, At, B0); PG8_MMA(1, 1, At, B1); PG8_BAR; PG8_SCHED;
            PG8_LDB(B0, 1, 0); PG8_LDB(B1, 1, 1); PG8_SCHED; PG8_LDA(At, 1, 0); PG8_STAGE(PG8_SA(0, 1), a2 + hstepA, voffA);
            PG8_WAIT_V(8); PG8_WAIT_L(0); PG8_BAR; PG8_MMA(0, 0, At, B0); PG8_MMA(0, 1, At, B1); PG8_BAR; PG8_SCHED;
            PG8_LDA(At, 1, 1); PG8_STAGE(PG8_SB(1, 0), b3, voffB); PG8_STAGE(PG8_SB(1, 1), b3 + hstepB, voffB); PG8_STAGE(PG8_SA(1, 0), a3, voffA);
            PG8_WAIT_V(8); PG8_WAIT_L(0); PG8_BAR; PG8_MMA(1, 0, At, B0); PG8_MMA(1, 1, At, B1); PG8_BAR; PG8_SCHED;
        }
        if (wr == 0) PG8_BAR;
        if constexpr (Epi::FUSED) E.fused(acc, cur, wr, wc, fr, fq, lds + STAGE_BYTES, wid, lane); else E(acc, cur, wr, wc, fr, fq);
        if (!has_next) break;
#pragma unroll
        for (int a = 0; a < 2; ++a)
#pragma unroll
            for (int b = 0; b < 2; ++b)
#pragma unroll
                for (int m = 0; m < 4; ++m)
#pragma unroll
                    for (int n = 0; n < 2; ++n) acc[a][b][m][n] = (f32x4){0.f, 0.f, 0.f, 0.f};
        cur = nxt; cA = nA; cB = nB; ++ui;
        if (wr == 1) PG8_BAR;
    }
    PG8_WAIT_V(0);
    PG8_BAR;
#undef PG8_UA
#undef PG8_UB
#undef PG8_SA
#undef PG8_SB
#undef PG8_STAGE
#undef PG8_LDA
#undef PG8_LDB
#undef PG8_MMA
#undef PG8_WAIT_V
#undef PG8_WAIT_L
#undef PG8_BAR
#undef PG8_SCHED
}
}

namespace attn {
constexpr int NW = 8, QBLK = 32, KVBLK = 64, KROW = 400;
constexpr int SHM_V = KVBLK * 128 * 2, SHM_K = KVBLK * KROW, SHM_ATTN = 2 * SHM_V + 2 * SHM_K + NW * 64 * 4;
#define SBAR() __builtin_amdgcn_sched_barrier(0)
__device__ __forceinline__ int crow(int r, int hi) { return (r & 3) + 8 * (r >> 2) + 4 * hi; }
__device__ __forceinline__ void partialSM(f32x16& p0, f32x16& p1, float& m_reg, float& mn, float& alpha) {
    float pmax = p0[0];
#pragma unroll
    for (int r = 1; r < 16; ++r) pmax = fmaxf(pmax, p0[r]);
#pragma unroll
    for (int r = 0; r < 16; ++r) pmax = fmaxf(pmax, p1[r]);
    { auto rr = __builtin_amdgcn_permlane32_swap(__float_as_uint(pmax), __float_as_uint(pmax), false, false);
      pmax = fmaxf(__uint_as_float(rr[0]), __uint_as_float(rr[1])); }
    if (__builtin_expect(__all(pmax - m_reg <= THR2), 1)) { mn = m_reg; alpha = 1.f; }
    else { mn = fmaxf(m_reg, pmax); alpha = __builtin_amdgcn_exp2f(m_reg - mn); m_reg = mn; }
#pragma unroll
    for (int r = 0; r < 16; ++r) p0[r] = p0[r] - mn;
#pragma unroll
    for (int r = 0; r < 16; ++r) p1[r] = p1[r] - mn;
#pragma unroll
    for (int r = 0; r < 16; ++r) p0[r] = __builtin_amdgcn_exp2f(p0[r]);
}
__device__ __forceinline__ void sm_decide(float pmax, float& m_reg, float& mn, float& alpha) {
    { auto rr = __builtin_amdgcn_permlane32_swap(__float_as_uint(pmax), __float_as_uint(pmax), false, false);
      pmax = fmaxf(__uint_as_float(rr[0]), __uint_as_float(rr[1])); }
    if (__builtin_expect(__all(pmax - m_reg <= THR2), 1)) { mn = m_reg; alpha = 1.f; }
    else { mn = fmaxf(m_reg, pmax); alpha = __builtin_amdgcn_exp2f(m_reg - mn); m_reg = mn; }
}
__device__ __forceinline__ void sm_tail(f32x16& p0, f32x16& p1, float mn) {
#pragma unroll
    for (int r = 0; r < 16; ++r) p0[r] = p0[r] - mn;
#pragma unroll
    for (int r = 0; r < 16; ++r) p1[r] = p1[r] - mn;
#pragma unroll
    for (int r = 0; r < 16; ++r) p0[r] = __builtin_amdgcn_exp2f(p0[r]);
}
__device__ __forceinline__ void finishSM(f32x16& p0, f32x16& p1, float alpha, float& l_reg, bf16x8& pa0, bf16x8& pa1, bf16x8& pa2, bf16x8& pa3) {
#pragma unroll
    for (int r = 0; r < 16; ++r) p1[r] = __builtin_amdgcn_exp2f(p1[r]);
    float ps = 0;
#pragma unroll
    for (int r = 0; r < 16; ++r) ps += p0[r];
#pragma unroll
    for (int r = 0; r < 16; ++r) ps += p1[r];
    { auto rr = __builtin_amdgcn_permlane32_swap(__float_as_uint(ps), __float_as_uint(ps), false, false);
      ps = __uint_as_float(rr[0]) + __uint_as_float(rr[1]); }
    l_reg = l_reg * alpha + ps;
#define PK4(P, BASE, OUT) do { unsigned a0 = cvt_pk_bf16(P[BASE + 0], P[BASE + 1]), a1 = cvt_pk_bf16(P[BASE + 2], P[BASE + 3]);   \
    unsigned b0 = cvt_pk_bf16(P[BASE + 4], P[BASE + 5]), b1 = cvt_pk_bf16(P[BASE + 6], P[BASE + 7]);                              \
    auto r0 = __builtin_amdgcn_permlane32_swap(a0, b0, false, false); auto r1 = __builtin_amdgcn_permlane32_swap(a1, b1, false, false); \
    u32x4 w = {r0[0], r1[0], r0[1], r1[1]}; OUT = *reinterpret_cast<bf16x8*>(&w); } while (0)
    PK4(p0, 0, pa0); PK4(p0, 8, pa1); PK4(p1, 0, pa2); PK4(p1, 8, pa3);
#undef PK4
}
__device__ __forceinline__ void qkt(f32x16& p0, f32x16& p1, const char* Ks, const bf16x8* qr, int r32, int hi) {
    p0 = f32x16{}; p1 = f32x16{};
#pragma unroll
    for (int d0 = 0; d0 < 12; ++d0) { const int cb = (d0 * 16 + hi * 8) * 2;
        const bf16x8 b0 = *reinterpret_cast<const bf16x8*>(Ks + r32 * KROW + cb);
        const bf16x8 b1 = *reinterpret_cast<const bf16x8*>(Ks + (32 + r32) * KROW + cb);
        p0 = __builtin_amdgcn_mfma_f32_32x32x16_bf16(b0, qr[d0], p0, 0, 0, 0);
        p1 = __builtin_amdgcn_mfma_f32_32x32x16_bf16(b1, qr[d0], p1, 0, 0, 0); }
}
__device__ __forceinline__ int v_st(int k, int c) { const int kk = (k & ~0xC) | ((k & 4) << 1) | ((k & 8) >> 1); return ((kk >> 3) * 4 + (c >> 5)) * 512 + ((kk & 7) * 32 + (c & 31)) * 2; }
__device__ __forceinline__ int v_rd_base(int lane) { return ((lane & 3) << 3) | (((lane >> 2) & 3) << 6) | (((lane >> 4) & 1) << 5) | (((lane >> 5) & 1) << 8); }
constexpr int v_rd_off(int d0, int ks, int half) { return d0 * 512 + ks * 4096 + half * 2048; }
template <int OFF> __device__ __forceinline__ s16x4 tr_read(int vb) {
    s16x4 r; asm volatile("ds_read_b64_tr_b16 %0, %1 offset:%2" : "=&v"(r) : "v"(vb), "i"(OFF) : "memory"); return r;
}
template <int D0> __device__ __forceinline__ void pv_one(f32x16& od, int vb, bf16x8 pa0, bf16x8 pa1, bf16x8 pa2, bf16x8 pa3) {
    const s16x4 l0 = tr_read<v_rd_off(D0, 0, 0)>(vb), h0 = tr_read<v_rd_off(D0, 0, 1)>(vb), l1 = tr_read<v_rd_off(D0, 1, 0)>(vb), h1 = tr_read<v_rd_off(D0, 1, 1)>(vb);
    const s16x4 l2 = tr_read<v_rd_off(D0, 2, 0)>(vb), h2 = tr_read<v_rd_off(D0, 2, 1)>(vb), l3 = tr_read<v_rd_off(D0, 3, 0)>(vb), h3 = tr_read<v_rd_off(D0, 3, 1)>(vb);
    asm volatile("s_waitcnt lgkmcnt(0)" ::: "memory"); SBAR();
#define PK(L, H) (bf16x8){L[0], L[1], L[2], L[3], H[0], H[1], H[2], H[3]}
    od = __builtin_amdgcn_mfma_f32_32x32x16_bf16(pa0, PK(l0, h0), od, 0, 0, 0);
    od = __builtin_amdgcn_mfma_f32_32x32x16_bf16(pa1, PK(l1, h1), od, 0, 0, 0);
    od = __builtin_amdgcn_mfma_f32_32x32x16_bf16(pa2, PK(l2, h2), od, 0, 0, 0);
    od = __builtin_amdgcn_mfma_f32_32x32x16_bf16(pa3, PK(l3, h3), od, 0, 0, 0);
#undef PK
}
template <int D0> __device__ __forceinline__ void pv_one_sm(f32x16& od, int vb, bf16x8 pa0, bf16x8 pa1, bf16x8 pa2, bf16x8 pa3, const f32x16& q0, const f32x16& q1, float& pmax) {
    const s16x4 l0 = tr_read<v_rd_off(D0, 0, 0)>(vb), h0 = tr_read<v_rd_off(D0, 0, 1)>(vb), l1 = tr_read<v_rd_off(D0, 1, 0)>(vb), h1 = tr_read<v_rd_off(D0, 1, 1)>(vb);
    const s16x4 l2 = tr_read<v_rd_off(D0, 2, 0)>(vb), h2 = tr_read<v_rd_off(D0, 2, 1)>(vb), l3 = tr_read<v_rd_off(D0, 3, 0)>(vb), h3 = tr_read<v_rd_off(D0, 3, 1)>(vb);
    {   const f32x16& q = (D0 < 2) ? q0 : q1; constexpr int B = (D0 & 1) * 8;
        float m = (D0 == 0) ? q[0] : pmax;
#pragma unroll
        for (int r = (D0 == 0) ? 1 : 0; r < 8; ++r) m = fmaxf(m, q[B + r]);
        pmax = m; }
    asm volatile("s_waitcnt lgkmcnt(0)" ::: "memory"); SBAR();
#define PK(L, H) (bf16x8){L[0], L[1], L[2], L[3], H[0], H[1], H[2], H[3]}
    od = __builtin_amdgcn_mfma_f32_32x32x16_bf16(pa0, PK(l0, h0), od, 0, 0, 0);
    od = __builtin_amdgcn_mfma_f32_32x32x16_bf16(pa1, PK(l1, h1), od, 0, 0, 0);
    od = __builtin_amdgcn_mfma_f32_32x32x16_bf16(pa2, PK(l2, h2), od, 0, 0, 0);
    od = __builtin_amdgcn_mfma_f32_32x32x16_bf16(pa3, PK(l3, h3), od, 0, 0, 0);
#undef PK
}
__device__ __forceinline__ void pv_sm(f32x16* o, int vb, bf16x8 pa0, bf16x8 pa1, bf16x8 pa2, bf16x8 pa3, const f32x16& q0, const f32x16& q1, float& pmax) {
    pv_one_sm<0>(o[0], vb, pa0, pa1, pa2, pa3, q0, q1, pmax); pv_one_sm<1>(o[1], vb, pa0, pa1, pa2, pa3, q0, q1, pmax);
    pv_one_sm<2>(o[2], vb, pa0, pa1, pa2, pa3, q0, q1, pmax); pv_one_sm<3>(o[3], vb, pa0, pa1, pa2, pa3, q0, q1, pmax);
}
__device__ __forceinline__ void pv_d0(f32x16* o, int vb, bf16x8 pa0, bf16x8 pa1, bf16x8 pa2, bf16x8 pa3) {
    pv_one<0>(o[0], vb, pa0, pa1, pa2, pa3); pv_one<1>(o[1], vb, pa0, pa1, pa2, pa3); pv_one<2>(o[2], vb, pa0, pa1, pa2, pa3); pv_one<3>(o[3], vb, pa0, pa1, pa2, pa3);
}
__device__ __forceinline__ void attn_unit(long rowb, int h, int q0, const bf16* Qn, const bf16* Qr, const bf16* __restrict__ Kn, const bf16* __restrict__ Kr, const bf16* __restrict__ Vv, bf16* O, char* lds) {
    int tid_ = threadIdx.x; asm volatile("" : "+v"(tid_));
    const int tid = tid_, wid = tid >> 6, lane = tid & 63, r32 = lane & 31, hi = lane >> 5;
    char* V_lds = lds; char* K_lds = lds + 2 * SHM_V;
    float* ws = (float*)(lds + 2 * SHM_V + 2 * SHM_K) + wid * 64; float* li_l = ws; float* al_l = ws + 32;
    float m_reg = -1e30f, l_reg = 0; f32x16 o[4] = {}; bf16x8 qr[12];
    const long qrow = rowb + q0 + wid * QBLK + r32;
#pragma unroll
    for (int d0 = 0; d0 < 8; ++d0) qr[d0] = *reinterpret_cast<const bf16x8*>(Qn + qrow * DM + h * 128 + d0 * 16 + hi * 8);
#pragma unroll
    for (int d0 = 0; d0 < 4; ++d0) qr[8 + d0] = *reinterpret_cast<const bf16x8*>(Qr + qrow * 512 + h * 64 + d0 * 16 + hi * 8);
    const int sr = tid >> 4, sc = (tid & 15) * 8, vst0 = v_st(sr, sc), vst1 = v_st(32 + sr, sc);
    const int ksr = tid >> 3, ksub = tid & 7;
    const int vb0 = (int)(uintptr_t)V_lds + v_rd_base(lane);
    const bf16* Vh = Vv + rowb * DM + h * 128; const bf16* Knh = Kn + rowb * DM + h * 128; const bf16* Krh = Kr + rowb * 64;
    bf16x8 vs0, vs1, ks0, ks1, ks2;
#define SLOAD(k0) do { vs0 = *(const bf16x8*)(Vh + (long)((k0) + sr) * DM + sc); vs1 = *(const bf16x8*)(Vh + (long)((k0) + 32 + sr) * DM + sc); \
    ks0 = *(const bf16x8*)(Knh + (long)((k0) + ksr) * DM + ksub * 8); ks1 = *(const bf16x8*)(Knh + (long)((k0) + ksr) * DM + 64 + ksub * 8); \
    ks2 = *(const bf16x8*)(Krh + (long)((k0) + ksr) * 64 + ksub * 8); } while (0)
#define SWRITE(b) do { *(bf16x8*)(V_lds + (b) * SHM_V + vst0) = vs0; *(bf16x8*)(V_lds + (b) * SHM_V + vst1) = vs1; \
    *(bf16x8*)(K_lds + (b) * SHM_K + ksr * KROW + ksub * 16) = ks0; *(bf16x8*)(K_lds + (b) * SHM_K + ksr * KROW + 128 + ksub * 16) = ks1; \
    *(bf16x8*)(K_lds + (b) * SHM_K + ksr * KROW + 256 + ksub * 16) = ks2; } while (0)
#define SWAIT() asm volatile("s_waitcnt vmcnt(0)" ::: "memory")
#define RESC(a) do { if (__any((a) < 1.f)) { if (hi == 0) al_l[r32] = (a); asm volatile("s_waitcnt lgkmcnt(0)" ::: "memory"); \
    _Pragma("unroll") for (int d = 0; d < 4; ++d) _Pragma("unroll") for (int r = 0; r < 16; ++r) o[d][r] *= al_l[crow(r, hi)]; } } while (0)
    f32x16 pA0, pA1, pB0, pB1; float mnA, mnB, alA, alB; bf16x8 pa0, pa1, pa2, pa3; constexpr int NT = SEQ / KVBLK;
    float pmx;
    if (__builtin_amdgcn_readfirstlane(tid) >= 256) __builtin_amdgcn_s_setprio(1);
    SLOAD(0); SWAIT(); SWRITE(0); SLOAD(KVBLK); __syncthreads();
    qkt(pA0, pA1, K_lds, qr, r32, hi);
    { pmx = pA0[0];
#pragma unroll
      for (int r = 1; r < 16; ++r) pmx = fmaxf(pmx, pA0[r]);
#pragma unroll
      for (int r = 0; r < 16; ++r) pmx = fmaxf(pmx, pA1[r]);
      sm_decide(pmx, m_reg, mnA, alA); }
    SWAIT(); SWRITE(1); __syncthreads();
    for (int j = 1; j + 1 < NT; j += 2) {
        SBAR(); qkt(pB0, pB1, K_lds + SHM_K, qr, r32, hi);
        sm_tail(pA0, pA1, mnA); finishSM(pA0, pA1, alA, l_reg, pa0, pa1, pa2, pa3); SBAR();
        SLOAD((j + 1) * KVBLK); SBAR();
        pv_sm(o, vb0, pa0, pa1, pa2, pa3, pB0, pB1, pmx); sm_decide(pmx, m_reg, mnB, alB);
        __syncthreads(); SWAIT(); SWRITE(0);
        RESC(alB); __syncthreads();
        SBAR(); qkt(pA0, pA1, K_lds, qr, r32, hi);
        sm_tail(pB0, pB1, mnB); finishSM(pB0, pB1, alB, l_reg, pa0, pa1, pa2, pa3); SBAR();
        SLOAD((j + 2) * KVBLK); SBAR();
        pv_sm(o, vb0 + SHM_V, pa0, pa1, pa2, pa3, pA0, pA1, pmx); sm_decide(pmx, m_reg, mnA, alA);
        __syncthreads(); SWAIT(); SWRITE(1);
        RESC(alA); __syncthreads();
    }
    SBAR(); qkt(pB0, pB1, K_lds + SHM_K, qr, r32, hi);
    sm_tail(pA0, pA1, mnA); finishSM(pA0, pA1, alA, l_reg, pa0, pa1, pa2, pa3); SBAR();
    pv_sm(o, vb0, pa0, pa1, pa2, pa3, pB0, pB1, pmx); sm_decide(pmx, m_reg, mnB, alB);
    __syncthreads(); RESC(alB);
    sm_tail(pB0, pB1, mnB); finishSM(pB0, pB1, alB, l_reg, pa0, pa1, pa2, pa3); SBAR();
    pv_d0(o, vb0 + SHM_V, pa0, pa1, pa2, pa3);
    __builtin_amdgcn_s_setprio(0);
    if (hi == 0) li_l[r32] = l_reg; asm volatile("s_waitcnt lgkmcnt(0)" ::: "memory");
    float rli[16];
#pragma unroll
    for (int r = 0; r < 16; ++r) rli[r] = __builtin_amdgcn_rcpf(li_l[crow(r, hi)]);
    bf16* Ow = O + (rowb + q0 + wid * QBLK) * DM + h * 128;
#pragma unroll
    for (int r = 0; r < 16; ++r) { const int orow = crow(r, hi);
#pragma unroll
        for (int d0 = 0; d0 < 4; ++d0) { const unsigned w = cvt_pk_bf16(o[d0][r] * rli[r], 0.f); Ow[(long)orow * DM + d0 * 32 + r32] = (bf16)(w & 0xffffu); } }
    __syncthreads();
#undef SLOAD
#undef SWRITE
#undef SWAIT
#undef RESC
}
#undef SBAR
}

__device__ __forceinline__ int rowmap(int mode, int n0) {
    if (mode == 0) return n0;
    if (mode == 1) return ((n0 >> 7) << 8) + (n0 & 127);
    if (mode == 2) return ((n0 >> 7) << 8) + 128 + (n0 & 127);
    if (mode == 4) { if (n0 < 640) return n0; const int c = n0 - 640, n = c >> 5, jj = c & 31; return 640 + 32 * (jj >> 4) + 8 * ((jj >> 2) & 3) + 4 * n + (jj & 3); }
    const int h = n0 / 192, d = n0 - h * 192;
    if (d < 128) return h * 128 + d;
    const int jj = d - 128;
    return 1024 + 256 * (h >> 2) + 128 * (jj >> 5) + 32 * (h & 3) + (jj & 31);
}
__device__ __forceinline__ void cvt_job(const float* W, int K, int N, bf16* WT, int mode, LAS float* scr, int gw, int NGW, int lane, int rot, bool f16 = false, const float* kscale = nullptr) {
    asm volatile("" : "+v"(lane));
    const int nblk = N / 32, nitems = (K / 64) * nblk;
    int start = gw - (rot % NGW); if (start < 0) start += NGW;
    for (int it = start; it < nitems; it += NGW) {
        const int kb = it / nblk, nb = it % nblk, k0 = 64 * kb, n0 = 32 * nb;
#pragma unroll 8
        for (int i = 0; i < 32; ++i) { const int kk = 2 * i + (lane >> 5); float w = W[(size_t)(k0 + kk) * N + n0 + (lane & 31)]; if (kscale) w *= kscale[k0 + kk]; scr[kk * 33 + (lane & 31)] = w; }
        asm volatile("s_waitcnt lgkmcnt(0)" ::: "memory");
        const int c = lane & 7;
#pragma unroll
        for (int j = 0; j < 4; ++j) { const int n = (lane >> 3) + 8 * j; const LAS float* s = scr + (8 * c) * 33 + n;
            u32x4 o;
            if (f16) {
                unsigned t0 = cvt_pk_bf16(s[0 * 33], s[1 * 33]), t1 = cvt_pk_bf16(s[2 * 33], s[3 * 33]), t2 = cvt_pk_bf16(s[4 * 33], s[5 * 33]), t3 = cvt_pk_bf16(s[6 * 33], s[7 * 33]);
                o.x = pk_f16(bf_lo(t0), bf_hi(t0)); o.y = pk_f16(bf_lo(t1), bf_hi(t1)); o.z = pk_f16(bf_lo(t2), bf_hi(t2)); o.w = pk_f16(bf_lo(t3), bf_hi(t3)); }
            else { o.x = cvt_pk_bf16(s[0 * 33], s[1 * 33]); o.y = cvt_pk_bf16(s[2 * 33], s[3 * 33]); o.z = cvt_pk_bf16(s[4 * 33], s[5 * 33]); o.w = cvt_pk_bf16(s[6 * 33], s[7 * 33]); }
            *(u32x4*)(WT + (size_t)rowmap(mode, n0 + n) * K + k0 + 8 * c) = o; }
        asm volatile("s_waitcnt lgkmcnt(0)" ::: "memory");
    }
}

struct Args { const float* in[20]; float* out; unsigned char* ws; int ph_lo, ph_hi; };

__device__ __forceinline__ void convert_layer(const Args& a, int L, LAS float* scr, int gw, int NGW, int lane) {
    asm volatile("" : "+v"(lane));
    unsigned char* wb = a.ws + WS_W;
    int rot = 0;
    for (int ff = 0; ff < 2; ++ff) {
        const size_t wo = (size_t)(L * 2 + ff) * DM * DFF;
        bf16* w13t = (bf16*)(wb + ff * W_FFN); bf16* w2t = (bf16*)(wb + ff * W_FFN + W_W2T);
        cvt_job(a.in[4] + wo, DM, DFF, w13t, 1, scr, gw, NGW, lane, rot, true); rot += 1408;
        cvt_job(a.in[5] + wo, DM, DFF, w13t, 2, scr, gw, NGW, lane, rot, true); rot += 1408;
        cvt_job(a.in[6] + wo, DFF, DM, w2t, 0, scr, gw, NGW, lane, rot); rot += 1408;
    }
    const int k = L >> 1;
    unsigned char* wm = wb + W_MIX;
    if ((L & 1) == 0) {
        bf16* w_in_t = (bf16*)(wm + W_MLA_IN);
        cvt_job(a.in[7] + (size_t)k * DM * 704, DM, 704, w_in_t, 4, scr, gw, NGW, lane, rot, true); rot += 352;
        for (int i = gw * 64 + lane; i < 64 * DM / 8; i += NGW * 64) *(u32x4*)(w_in_t + (size_t)704 * DM + (size_t)i * 8) = (u32x4){0u, 0u, 0u, 0u};
        cvt_job(a.in[10] + (size_t)k * QLR * 1536, QLR, 1536, (bf16*)(wm + W_MLA_UQ), 3, scr, gw, NGW, lane, rot, false, a.in[8] + k * QLR); rot += 288;
        cvt_job(a.in[11] + (size_t)k * KVLR * 2048, KVLR, 2048, (bf16*)(wm + W_MLA_UKV), 0, scr, gw, NGW, lane, rot, false, a.in[9] + k * KVLR); rot += 256;
        cvt_job(a.in[12] + (size_t)k * DM * DM, DM, DM, (bf16*)(wm + W_MLA_O), 0, scr, gw, NGW, lane, rot);
    } else {
        cvt_job(a.in[13] + (size_t)k * DM * 2048, DM, 2048, (bf16*)(wm + W_LRU_IN), 0, scr, gw, NGW, lane, rot, true); rot += 1024;
        for (int gn = 0; gn < 16; ++gn) { const int gate = gn >> 2, n = gn & 3;
            cvt_job(a.in[16] + (size_t)((k * 4 + gate) * 4 + n) * 65536, 256, 256, (bf16*)(wm + W_LRU_GATE) + (size_t)(((gate >> 1) * 4 + n) * 2) * 65536, (gate & 1) ? 2 : 1, scr, gw, NGW, lane, rot); rot += 32; }
        cvt_job(a.in[19] + (size_t)k * DM * DM, DM, DM, (bf16*)(wm + W_LRU_OUT), 0, scr, gw, NGW, lane, rot);
    }
}

__device__ __forceinline__ void cast_rows(const float* __restrict__ X, bf16* __restrict__ XN, int gw, int NGW, int lane) {
    asm volatile("" : "+v"(lane));
    for (int m = gw * 4; m < M; m += NGW * 4) {
        f32x4 v[4][4];
#pragma unroll
        for (int r = 0; r < 4; ++r)
#pragma unroll
            for (int j = 0; j < 4; ++j) v[r][j] = ((const f32x4*)(X + (size_t)(m + r) * DM))[lane + 64 * j];
#pragma unroll
        for (int r = 0; r < 4; ++r) { u32x2* o = (u32x2*)(XN + (size_t)(m + r) * DM) + lane;
#pragma unroll
            for (int j = 0; j < 4; ++j) o[64 * j] = (u32x2){pk_f16(v[r][j][0], v[r][j][1]), pk_f16(v[r][j][2], v[r][j][3])}; }
    }
}
__device__ __forceinline__ void ln_pass(const float* X, float* XO, bf16* XN, const float* g, const float* bt, int gw, int NGW, int lane) {
    asm volatile("" : "+v"(lane));
    f32x4 gv[4], bv[4];
#pragma unroll
    for (int j = 0; j < 4; ++j) { gv[j] = ((const f32x4*)g)[lane + 64 * j]; bv[j] = ((const f32x4*)bt)[lane + 64 * j]; }
    for (int m = gw; m < M; m += NGW) {
        const f32x4* xr = (const f32x4*)(X + (size_t)m * DM) + lane; f32x4* xo = (f32x4*)(XO + (size_t)m * DM) + lane; u32x2* o = (u32x2*)(XN + (size_t)m * DM) + lane;
        f32x4 v[4]; float s = 0.f;
#pragma unroll
        for (int j = 0; j < 4; ++j) { v[j] = xr[64 * j]; s += (v[j][0] + v[j][1]) + (v[j][2] + v[j][3]); }
        const float mean = wave_sum(s) * (1.f / DM); float s2 = 0.f;
#pragma unroll
        for (int j = 0; j < 4; ++j) { v[j] = v[j] - mean; s2 += (v[j][0] * v[j][0] + v[j][1] * v[j][1]) + (v[j][2] * v[j][2] + v[j][3] * v[j][3]); }
        const float rstd = 1.0f / sqrtf(wave_sum(s2) * (1.f / DM) + LN_EPS);
#pragma unroll
        for (int j = 0; j < 4; ++j) { const f32x4 y = v[j] * rstd * gv[j] + bv[j]; xo[64 * j] = y; o[64 * j] = (u32x2){cvt_pk_bf16(y[0], y[1]), cvt_pk_bf16(y[2], y[3])}; }
    }
}
__device__ __forceinline__ void mla_norm_pass(const float* hm, bf16* cqn, bf16* ckvn, bf16* Kr, const float* qg, const float* kvg, const int* pos, int gw, int NGW, int lane) {
    asm volatile("" : "+v"(lane));
    for (int m = gw; m < M; m += NGW) {
        const float* r = hm + (size_t)m * 768;
        const f32x2 a0 = *(const f32x2*)(r + 6 * lane), a1 = *(const f32x2*)(r + 6 * lane + 2), a2 = *(const f32x2*)(r + 6 * lane + 4);
        const f32x4 kv = *(const f32x4*)(r + 384 + 4 * lane);
        const float kr = r[640 + lane];
        const float sq = wave_sum((a0[0] * a0[0] + a0[1] * a0[1]) + (a1[0] * a1[0] + a1[1] * a1[1]) + (a2[0] * a2[0] + a2[1] * a2[1]));
        const float skv = wave_sum((kv[0] * kv[0] + kv[1] * kv[1]) + (kv[2] * kv[2] + kv[3] * kv[3]));
        const float rq = 1.0f / sqrtf(sq * (1.f / QLR) + RMS_EPS), rkv = 1.0f / sqrtf(skv * (1.f / KVLR) + RMS_EPS);
        const f32x2 g0 = *(const f32x2*)(qg + 6 * lane), g1 = *(const f32x2*)(qg + 6 * lane + 2), g2 = *(const f32x2*)(qg + 6 * lane + 4);
        unsigned* oq = (unsigned*)(cqn + (size_t)m * QLR + 6 * lane);
        oq[0] = cvt_pk_bf16(a0[0] * rq * g0[0], a0[1] * rq * g0[1]); oq[1] = cvt_pk_bf16(a1[0] * rq * g1[0], a1[1] * rq * g1[1]); oq[2] = cvt_pk_bf16(a2[0] * rq * g2[0], a2[1] * rq * g2[1]);
        const f32x4 gk = *(const f32x4*)(kvg + 4 * lane);
        *(u32x2*)(ckvn + (size_t)m * KVLR + 4 * lane) = (u32x2){cvt_pk_bf16(kv[0] * rkv * gk[0], kv[1] * rkv * gk[1]), cvt_pk_bf16(kv[2] * rkv * gk[2], kv[3] * rkv * gk[3])};
        const float other = __shfl_xor(kr, 32);
        float c, s; rope_cs(pos[m], lane & 31, c, s);
        const float outv = (lane < 32) ? (kr * c - other * s) : (kr * c + other * s);
        Kr[(size_t)m * 64 + lane] = (bf16)(cvt_pk_bf16(outv, 0.f) & 0xffffu);
    }
}
__device__ __forceinline__ void conv_pass(const bf16* __restrict__ xr, bf16* __restrict__ xc, const float* __restrict__ cw, const float* __restrict__ cb, int gw, int NGW, int lane) {
    asm volatile("" : "+v"(lane));
    constexpr int RPW = 16;
    for (int blk = gw; blk < M / RPW; blk += NGW) {
        const int m0 = blk * RPW, t0 = m0 & (SEQ - 1);
#pragma unroll
        for (int half = 0; half < 2; ++half) {
            const int c0 = half * 512 + lane * 8;
            u32x4 rows[RPW + 3];
#pragma unroll
            for (int i = 0; i < RPW + 3; ++i) { const int tt = t0 + i - 2;
                rows[i] = (tt >= 0 && tt < SEQ) ? *(const u32x4*)(xr + (size_t)(m0 + i - 2) * DM + c0) : (u32x4){0u, 0u, 0u, 0u}; }
            f32x4 k0[4], k1[4];
#pragma unroll
            for (int j = 0; j < 4; ++j) { k0[j] = *(const f32x4*)(cw + j * DM + c0); k1[j] = *(const f32x4*)(cw + j * DM + c0 + 4); }
            const f32x4 b0 = *(const f32x4*)(cb + c0), b1 = *(const f32x4*)(cb + c0 + 4);
#pragma unroll
            for (int i = 0; i < RPW; ++i) {
                f32x4 a0 = b0, a1 = b1;
#pragma unroll
                for (int j = 0; j < 4; ++j) { const u32x4 w = rows[i + j];
                    a0[0] += k0[j][0] * bf_lo(w.x); a0[1] += k0[j][1] * bf_hi(w.x); a0[2] += k0[j][2] * bf_lo(w.y); a0[3] += k0[j][3] * bf_hi(w.y);
                    a1[0] += k1[j][0] * bf_lo(w.z); a1[1] += k1[j][1] * bf_hi(w.z); a1[2] += k1[j][2] * bf_lo(w.w); a1[3] += k1[j][3] * bf_hi(w.w); }
                *(u32x4*)(xc + (size_t)(m0 + i) * DM + c0) = (u32x4){cvt_pk_bf16(a0[0], a0[1]), cvt_pk_bf16(a0[2], a0[3]), cvt_pk_bf16(a1[0], a1[1]), cvt_pk_bf16(a1[2], a1[3])};
            }
        }
    }
}
constexpr int NCHUNK = 32, CLEN = SEQ / NCHUNK;
__device__ __forceinline__ void scan_pass1(const unsigned* P, f32x2* agg, int tid_in, int bx, int gthreads) {
    asm volatile("" : "+v"(tid_in)); const int gtid = bx * 512 + tid_in;
    f32x4* agg4 = (f32x4*)agg;
    for (int T = gtid; T < BATCH * NCHUNK * (DM / 2); T += gthreads) {
        const int chp = T & 511, chunk = (T >> 9) & (NCHUNK - 1), b = T >> 14;
        const size_t base = ((size_t)b * SEQ + (size_t)chunk * CLEN) * DM + 2 * chp;
        {   const u32x2* p = (const u32x2*)(P + base); float h0 = 0.f, s0 = 0.f, h1 = 0.f, s1 = 0.f;
            for (int t0 = 0; t0 < CLEN; t0 += 16) { u32x2 w[16];
#pragma unroll
                for (int i = 0; i < 16; ++i) w[i] = p[(size_t)(t0 + i) * (DM / 2)];
#pragma unroll
                for (int i = 0; i < 16; ++i) { const float la = bf_lo(w[i].x), lb = bf_lo(w[i].y); h0 = __builtin_amdgcn_exp2f(la) * h0 + bf_hi(w[i].x); s0 += la; h1 = __builtin_amdgcn_exp2f(lb) * h1 + bf_hi(w[i].y); s1 += lb; } }
            agg4[((size_t)(0 * BATCH + b) * NCHUNK + chunk) * (DM / 2) + chp] = (f32x4){s0, h0, s1, h1}; }
        {   const u32x2* p = (const u32x2*)(P + (size_t)M * DM + base); float h0 = 0.f, s0 = 0.f, h1 = 0.f, s1 = 0.f;
            for (int t0 = CLEN - 16; t0 >= 0; t0 -= 16) { u32x2 w[16];
#pragma unroll
                for (int i = 0; i < 16; ++i) w[i] = p[(size_t)(t0 + i) * (DM / 2)];
#pragma unroll
                for (int i = 15; i >= 0; --i) { const float la = bf_lo(w[i].x), lb = bf_lo(w[i].y); h0 = __builtin_amdgcn_exp2f(la) * h0 + bf_hi(w[i].x); s0 += la; h1 = __builtin_amdgcn_exp2f(lb) * h1 + bf_hi(w[i].y); s1 += lb; } }
            agg4[((size_t)(1 * BATCH + b) * NCHUNK + chunk) * (DM / 2) + chp] = (f32x4){s0, h0, s1, h1}; }
    }
}
__device__ __forceinline__ void scan_pass2(const unsigned* P, const f32x2* agg, bf16* HF, bf16* GG, int tid_in, int bx, int gthreads) {
    asm volatile("" : "+v"(tid_in)); const int gtid = bx * 512 + tid_in;
    const f32x4* agg4 = (const f32x4*)agg;
    for (int T = gtid; T < BATCH * NCHUNK * (DM / 2); T += gthreads) {
        const int chp = T & 511, chunk = (T >> 9) & (NCHUNK - 1), b = T >> 14;
        const size_t base = ((size_t)b * SEQ + (size_t)chunk * CLEN) * DM + 2 * chp;
        {   float h0 = 0.f, h1 = 0.f;
            const f32x4* ag = agg4 + ((size_t)(0 * BATCH + b) * NCHUNK) * (DM / 2) + chp;
            for (int c0 = 0; c0 < chunk; c0 += 8) { f32x4 ab[8];
#pragma unroll
                for (int i = 0; i < 8; ++i) ab[i] = ag[(size_t)(c0 + i) * (DM / 2)];
#pragma unroll
                for (int i = 0; i < 8; ++i) if (c0 + i < chunk) { h0 = __builtin_amdgcn_exp2f(ab[i][0]) * h0 + ab[i][1]; h1 = __builtin_amdgcn_exp2f(ab[i][2]) * h1 + ab[i][3]; } }
            const u32x2* p = (const u32x2*)(P + base); unsigned* hf = (unsigned*)(HF + base);
            for (int t0 = 0; t0 < CLEN; t0 += 16) { u32x2 w[16];
#pragma unroll
                for (int i = 0; i < 16; ++i) w[i] = p[(size_t)(t0 + i) * (DM / 2)];
#pragma unroll
                for (int i = 0; i < 16; ++i) { h0 = __builtin_amdgcn_exp2f(bf_lo(w[i].x)) * h0 + bf_hi(w[i].x); h1 = __builtin_amdgcn_exp2f(bf_lo(w[i].y)) * h1 + bf_hi(w[i].y);
                    hf[(size_t)(t0 + i) * (DM / 2)] = cvt_pk_bf16(h0, h1); } } }
        __threadfence_block();
        {   float h0 = 0.f, h1 = 0.f;
            const f32x4* ag = agg4 + ((size_t)(1 * BATCH + b) * NCHUNK) * (DM / 2) + chp;
            for (int c0 = NCHUNK - 1; c0 > chunk; c0 -= 8) { f32x4 ab[8];
#pragma unroll
                for (int i = 0; i < 8; ++i) ab[i] = ag[(size_t)(c0 - i) * (DM / 2)];
#pragma unroll
                for (int i = 0; i < 8; ++i) if (c0 - i > chunk) { h0 = __builtin_amdgcn_exp2f(ab[i][0]) * h0 + ab[i][1]; h1 = __builtin_amdgcn_exp2f(ab[i][2]) * h1 + ab[i][3]; } }
            const u32x2* p = (const u32x2*)(P + (size_t)M * DM + base); const unsigned* hf = (const unsigned*)(HF + base); unsigned* gg = (unsigned*)(GG + base);
            for (int t0 = CLEN - 16; t0 >= 0; t0 -= 16) { u32x2 w[16]; unsigned f[16], g[16];
#pragma unroll
                for (int i = 0; i < 16; ++i) { w[i] = p[(size_t)(t0 + i) * (DM / 2)]; f[i] = hf[(size_t)(t0 + i) * (DM / 2)]; g[i] = gg[(size_t)(t0 + i) * (DM / 2)]; }
#pragma unroll
                for (int i = 15; i >= 0; --i) { h0 = __builtin_amdgcn_exp2f(bf_lo(w[i].x)) * h0 + bf_hi(w[i].x); h1 = __builtin_amdgcn_exp2f(bf_lo(w[i].y)) * h1 + bf_hi(w[i].y);
                    gg[(size_t)(t0 + i) * (DM / 2)] = cvt_pk_bf16(bf_lo(g[i]) * (bf_lo(f[i]) + h0), bf_hi(g[i]) * (bf_hi(f[i]) + h1)); } } }
    }
}

#define XB_TMO      128
#define XB_XCNT(j)  (256  + 64 * (j))
#define XB_XSUB(j)  (1280 + 64 * (j))
#define XB_XGEN(j)  (2304 + 64 * (j))
#define XB_TOP      3328
#define XB_TOPGEN   3392
#define XCD_BAR_WORDS 3456
#define XB_SPIN_CAP (1u << 18)
__device__ __forceinline__ unsigned xb_ld(unsigned* p)              { return __hip_atomic_load(p, __ATOMIC_RELAXED, __HIP_MEMORY_SCOPE_AGENT); }
__device__ __forceinline__ unsigned xb_add(unsigned* p, unsigned v) { return __hip_atomic_fetch_add(p, v, __ATOMIC_RELAXED, __HIP_MEMORY_SCOPE_AGENT); }
__device__ __forceinline__ unsigned xb_xcc_id() { return (unsigned)__builtin_amdgcn_s_getreg((3 << 11) | 20) & 0xFu; }
#define XB_SPIN(cond, bar) do { unsigned _sp = 0; while (cond) { __builtin_amdgcn_s_sleep(1); \
    if ((++_sp & 255u) == 0u) { if (xb_ld(&(bar)[XB_TMO])) break; if (_sp > XB_SPIN_CAP) { atomicAdd(&(bar)[XB_TMO], 1u); break; } } } } while (0)
struct XcdBarrier { unsigned* bar; unsigned x; volatile LAS unsigned* st; };
__device__ __forceinline__ XcdBarrier xcd_barrier_post(unsigned* bar, volatile LAS unsigned* st) {
    XcdBarrier b; b.bar = bar; b.x = xb_xcc_id(); b.st = st;
    if (threadIdx.x == 0) (void)xb_add(&bar[XB_XCNT(b.x)], 1u);
    return b;
}
__device__ __forceinline__ void xcd_barrier_complete(unsigned* bar, unsigned x, unsigned& nloc, unsigned& nx) {
    const unsigned G = gridDim.x * gridDim.y * gridDim.z;
    unsigned sum, cnt, mine, sp = 0u;
    for (;;) {
        sum = 0u; cnt = 0u; mine = 0u;
#pragma unroll
        for (unsigned j = 0; j < 16; ++j) { const unsigned c = xb_ld(&bar[XB_XCNT(j)]); sum += c; cnt += (c > 0u) ? 1u : 0u; mine = (j == x) ? c : mine; }
        if (sum == G) break;
        __builtin_amdgcn_s_sleep(1);
        if ((++sp & 255u) == 0u) { if (xb_ld(&bar[XB_TMO])) break; if (sp > XB_SPIN_CAP) { atomicAdd(&bar[XB_TMO], 1u); break; } }
    }
    nloc = mine > 0u ? mine : 1u; nx = cnt > 0u ? cnt : 1u;
}
__device__ __forceinline__ void xcd_barrier(const XcdBarrier& b) {
    asm volatile("s_waitcnt vmcnt(0)" ::: "memory");
    __syncthreads();
    if (threadIdx.x == 0) {
        unsigned* bar = b.bar;
        __builtin_amdgcn_s_waitcnt(0);
        unsigned nloc = b.st[0], nx = b.st[1];
        if (nloc == 0u) { xcd_barrier_complete(bar, b.x, nloc, nx); b.st[0] = nloc; b.st[1] = nx; }
        const unsigned old = xb_add(&bar[XB_XSUB(b.x)], 1u);
        const unsigned gen = old / nloc;
        if (old + 1u == (gen + 1u) * nloc) {
            __builtin_amdgcn_fence(__ATOMIC_RELEASE, "agent");
            asm volatile("s_waitcnt vmcnt(0)" ::: "memory");
            const unsigned og = xb_add(&bar[XB_TOP], 1u);
            const unsigned tg = og / nx;
            if (og + 1u == (tg + 1u) * nx) xb_add(&bar[XB_TOPGEN], 1u);
            else XB_SPIN(xb_ld(&bar[XB_TOPGEN]) == tg, bar);
            __builtin_amdgcn_fence(__ATOMIC_ACQUIRE, "agent");
            xb_add(&bar[XB_XGEN(b.x)], 1u);
            asm volatile("s_waitcnt vmcnt(0)" ::: "memory");
        } else {
            XB_SPIN(xb_ld(&bar[XB_XGEN(b.x)]) == gen, bar);
            __builtin_amdgcn_fence(__ATOMIC_ACQUIRE, "agent");
            asm volatile("s_waitcnt vmcnt(0)" ::: "memory");
        }
    }
    __syncthreads();
}

constexpr int LDS_BYTES = 147456;
static_assert(attn::SHM_ATTN <= pg8::STAGE_BYTES, "attention LDS fits the stage region");

__global__ void __launch_bounds__(512, 2) fwd_megakernel(Args a) {
    extern __shared__ __attribute__((aligned(16))) unsigned char lds[];
    cg::grid_group grid = cg::this_grid();
    const int tid = threadIdx.x, lane = tid & 63, wave = __builtin_amdgcn_readfirstlane(tid >> 6);
    const int G = gridDim.x, bx = blockIdx.x;
    const int gw = bx * 8 + wave, NGW = G * 8;
    const int vcu = (G % 8 == 0) ? (bx % 8) * (G / 8) + bx / 8 : bx;
    LAS unsigned char* ldsl = (LAS unsigned char*)lds;
    LAS float* scr = (LAS float*)(ldsl + wave * 16384);
    unsigned char* ws = a.ws;
    const float* x_in = a.in[0]; const int* pos = (const int*)a.in[1];
    float* xbuf = a.out;
    bf16* xn = (bf16*)(ws + WS_R0);
    unsigned char* T = ws + WS_T;
    unsigned char* wb = ws + WS_W;
    int ph = 0;
    volatile LAS unsigned* bst = (volatile LAS unsigned*)(ldsl + 131072 + 12288);
    if (tid < 2) bst[tid] = 0u;
    __syncthreads();
    XcdBarrier bar = xcd_barrier_post((unsigned*)ws + 1024, bst);
    int nsync = 0;
    unsigned long long* xslots = (unsigned long long*)(ws + 42 * MiB);
#ifndef ONLY
#define ONLY -1
#endif
#define EN(k) (ONLY < 0 || ONLY == (k))
#define RUN(p) (a.ph_lo <= (p) && (p) < a.ph_hi)
#define SEAM() do { if (RUN(ph) && RUN(ph + 1)) { if (nsync == 0) grid.sync(); else { xcd_barrier(bar); } ++nsync; } ++ph; } while (0)

    if (EN(0) && RUN(ph)) { { int tl = tid; asm volatile("" : "+v"(tl)); for (int i = bx * 512 + tl; i < 2 * M * 2; i += G * 512) ((float*)(ws + 43 * MiB))[i] = 0.f; }
        convert_layer(a, 0, scr, gw, NGW, lane); cast_rows(x_in, xn, gw, NGW, lane); }
    SEAM();

#pragma nounroll
    for (int s = 0; s < 3 * DEPTH; ++s) {
        const int L = s / 3, j = s - 3 * L;
        if (j != 1) {
            const int ff = j >> 1;
            bf16* hbuf = (bf16*)(T + T_H);
            if (EN(1) && RUN(ph)) {
                pg8::Gemm g{xn, (const bf16*)(wb + ff * W_FFN), DM, DM, DM, 0, 0, 0}; pg8::StaticOrder S; S.init(M, 2 * DFF, G, bx);
                pg8::EpiSwiglu E{hbuf, DFF};
                pg8::gemm_phase<pg8::EpiSwiglu>(ldsl, g, S, E);
            }
            SEAM();
            if (EN(2) && RUN(ph)) {
                pg8::Gemm g{hbuf, (const bf16*)(wb + ff * W_FFN + W_W2T), DFF, DFF, DFF, 0, 0, 0}; pg8::StaticOrder S; S.init(M, DM, G, bx);
                pg8::EpiResid E{xn, xbuf, (s == 3 * DEPTH - 1) ? 1 : 0, ALPHA, 0.5f, a.in[2] + (size_t)s * DM, a.in[3] + (size_t)s * DM, xslots, 16u + (unsigned)s, (unsigned*)ws + 16};
                pg8::gemm_phase<pg8::EpiResid>(ldsl, g, S, E);
            }
            SEAM();
        } else if ((L & 1) == 0) {
            const int k = L >> 1;
            unsigned char* wm = wb + W_MIX;
            float* mstat = (float*)(ws + 43 * MiB) + (size_t)k * M * 2;
            bf16* Qn = (bf16*)(T + T_QN); bf16* Qr = (bf16*)(T + T_QR); bf16* cqn = (bf16*)(T + T_CQN); bf16* ckvn = (bf16*)(T + T_CKVN);
            bf16* Kn = (bf16*)(T + T_KN); bf16* Kr = (bf16*)(T + T_KR); bf16* Vb = (bf16*)(T + T_V);
            if (EN(3) && RUN(ph)) {
                pg8::Gemm g{xn, (const bf16*)(wm + W_MLA_IN), DM, DM, DM, 0, 0, 0}; pg8::StaticOrder S; S.init(M, 768, G, bx);
                pg8::EpiMlaIn E{cqn, ckvn, Kr, mstat, pos};
                pg8::gemm_phase<pg8::EpiMlaIn>(ldsl, g, S, E);
            }
            SEAM();
            if (RUN(ph)) {
                if (EN(5)) { pg8::Gemm g{cqn, (const bf16*)(wm + W_MLA_UQ), QLR, QLR, QLR, 0, 0, 0}; pg8::StaticOrder S; S.init(M, 1536, G, bx);
                  pg8::EpiQ E{Qn, Qr, pos, mstat};
                  pg8::gemm_phase<pg8::EpiQ>(ldsl, g, S, E); }
                if (EN(6)) { pg8::Gemm g{ckvn, (const bf16*)(wm + W_MLA_UKV), KVLR, KVLR, KVLR, 0, 0, 0}; pg8::StaticOrder S; S.init(M, 2048, G, bx);
                  pg8::EpiKV E{Kn, Vb, mstat};
                  pg8::gemm_phase<pg8::EpiKV>(ldsl, g, S, E); }
            }
            SEAM();
            if (EN(7) && RUN(ph)) {
                for (int U = vcu; U < BATCH * HEADS * (SEQ / 256); U += G) {
                    const int bh = U >> 4, qb = U & 15, b = bh >> 3, h = bh & 7;
                    attn::attn_unit((long)b * SEQ, h, qb * 256, Qn, Qr, Kn, Kr, Vb, Qn, (char*)lds);
                }
            }
            SEAM();
            if (EN(8) && RUN(ph)) {
                pg8::Gemm g{Qn, (const bf16*)(wm + W_MLA_O), DM, DM, DM, 0, 0, 0}; pg8::StaticOrder S; S.init(M, DM, G, bx);
                pg8::EpiResid E{xn, xbuf, 0, ALPHA, 1.0f, a.in[2] + (size_t)s * DM, a.in[3] + (size_t)s * DM, xslots, 16u + (unsigned)s, (unsigned*)ws + 16};
                pg8::gemm_phase<pg8::EpiResid>(ldsl, g, S, E);
            }
            SEAM();
        } else {
            const int k = L >> 1;
            unsigned char* wm = wb + W_MIX;
            bf16* gg = (bf16*)(T + T_GG); bf16* xr = (bf16*)(T + T_XR); unsigned* P = (unsigned*)(T + T_P); f32x2* agg = (f32x2*)(T + T_AGG);
            bf16* xc = (bf16*)xbuf;
            if (EN(9) && RUN(ph)) {
                pg8::Gemm g{xn, (const bf16*)(wm + W_LRU_IN), DM, DM, DM, 0, 0, 0}; pg8::StaticOrder S; S.init(M, 2048, G, bx);
                pg8::EpiLruIn E{gg, xr};
                pg8::gemm_phase<pg8::EpiLruIn>(ldsl, g, S, E);
            }
            SEAM();
            float* lstab = (float*)(T + T_AGG + 4 * MiB);
            if (EN(10) && RUN(ph) && bx == 0) { const float* lm = a.in[18] + (size_t)k * 2 * DM; int tl = tid; asm volatile("" : "+v"(tl)); for (int i = tl; i < 2 * DM; i += 512) lstab[i] = -8.0f * LOG2E * logf(1.0f + expf(-lm[i])); }
            if (EN(10) && RUN(ph)) conv_pass(xr, xc, a.in[14] + (size_t)k * 4 * DM, a.in[15] + (size_t)k * DM, gw, NGW, lane);
            SEAM();
            if (EN(11) && RUN(ph)) {
                pg8::Gemm g{xc, (const bf16*)(wm + W_LRU_GATE), DM, 256, 256, 1, 3, 256}; pg8::StaticOrder S; S.init(M, 4096, G, bx);
                pg8::EpiGate E{P, xc, a.in[17] + (size_t)k * 4 * DM, lstab};
                pg8::gemm_phase<pg8::EpiGate>(ldsl, g, S, E);
            }
            SEAM();
            if (EN(12) && RUN(ph)) scan_pass1(P, agg, tid, bx, G * 512);
            SEAM();
            if (EN(13) && RUN(ph)) scan_pass2(P, agg, xc, gg, tid, bx, G * 512);
            SEAM();
            if (EN(14) && RUN(ph)) {
                pg8::Gemm g{gg, (const bf16*)(wm + W_LRU_OUT), DM, DM, DM, 0, 0, 0}; pg8::StaticOrder S; S.init(M, DM, G, bx);
                pg8::EpiResid E{xn, xbuf, 0, ALPHA, 1.0f, a.in[2] + (size_t)s * DM, a.in[3] + (size_t)s * DM, xslots, 16u + (unsigned)s, (unsigned*)ws + 16};
                pg8::gemm_phase<pg8::EpiResid>(ldsl, g, S, E);
            }
            SEAM();
        }
        if (j == 2 && L + 1 < DEPTH) {
            if (EN(15) && RUN(ph)) convert_layer(a, L + 1, scr, gw, NGW, lane);
            SEAM();
        }
    }
#undef RUN
#undef SEAM
}

extern "C" void kernel_launch(void* const* d_in, const int* in_sizes, int n_in, void* d_out, int out_size, void* d_ws, size_t ws_size, hipStream_t stream) {
    static int grid = 0;
    if (grid == 0) {
        if (n_in != 20 || in_sizes[0] != M * DM || out_size != M * DM || ws_size < WS_END) {
            fprintf(stderr, "kernel_launch: unexpected shapes (n_in %d, in0 %d, out %d, ws %zu need %zu)\n", n_in, n_in > 0 ? in_sizes[0] : -1, out_size, ws_size, (size_t)WS_END); grid = -1; return; }
        int dev = 0, cus = 0, per_cu = 0;
        hipGetDevice(&dev); hipDeviceGetAttribute(&cus, hipDeviceAttributeMultiprocessorCount, dev);
        if (hipFuncSetAttribute((const void*)fwd_megakernel, hipFuncAttributeMaxDynamicSharedMemorySize, LDS_BYTES) != hipSuccess) { fprintf(stderr, "kernel_launch: hipFuncSetAttribute failed\n"); grid = -1; return; }
        if (hipOccupancyMaxActiveBlocksPerMultiprocessor(&per_cu, (const void*)fwd_megakernel, 512, LDS_BYTES) != hipSuccess || per_cu < 1) { fprintf(stderr, "kernel_launch: occupancy query gives %d\n", per_cu); per_cu = 1; }
        (void)hipGetLastError();
        grid = cus;
    }
    if (grid < 0) return;
    if (hipMemsetAsync(d_ws, 0, 65536, stream) != hipSuccess) { fprintf(stderr, "kernel_launch: memset failed\n"); return; }
    Args a{};
    for (int i = 0; i < 20; ++i) a.in[i] = (const float*)d_in[i];
    a.out = (float*)d_out; a.ws = (unsigned char*)d_ws;
#if MK_PER_PHASE
    for (int p = 0; p < N_PHASES; ++p) { a.ph_lo = p; a.ph_hi = p + 1; hipLaunchKernelGGL(fwd_megakernel, dim3(grid), dim3(512), LDS_BYTES, stream, a); }
#else
    a.ph_lo = 0; a.ph_hi = 1 << 20;
    void* args[] = {&a};
    hipError_t e = hipLaunchCooperativeKernel((const void*)fwd_megakernel, dim3(grid), dim3(512), args, LDS_BYTES, stream);
    if (e != hipSuccess) fprintf(stderr, "kernel_launch: cooperative launch failed: %s (grid %d)\n", hipGetErrorString(e), grid);
#endif
}
```

```cpp
#include <hip/hip_runtime.h>
#include <hip/hip_cooperative_groups.h>
#include <cstdio>
#include <cstdint>
namespace cg = cooperative_groups;

#ifndef MK_PER_PHASE
#define MK_PER_PHASE 0
#endif

#define LAS __attribute__((address_space(3)))
typedef unsigned short bf16;
typedef short bf16x8 __attribute__((ext_vector_type(8)));
typedef short s16x4 __attribute__((ext_vector_type(4)));
typedef float f32x4 __attribute__((ext_vector_type(4)));
typedef float f32x2 __attribute__((ext_vector_type(2)));
typedef float f32x16 __attribute__((ext_vector_type(16)));
typedef unsigned u32x4 __attribute__((ext_vector_type(4)));
typedef unsigned u32x2 __attribute__((ext_vector_type(2)));

constexpr int BATCH = 8, SEQ = 4096, DM = 1024, M = BATCH * SEQ, DFF = 2816, DEPTH = 4;
constexpr int HEADS = 8, QLR = 384, KVLR = 256;
constexpr float ALPHA = 1.681792830507429f;
constexpr float LN_EPS = 1e-5f, RMS_EPS = 1e-6f;
constexpr float QSCALE = 0.10411754627697264f;
constexpr float THR2 = 11.541560327111707f;
constexpr float LOG2E = 1.4426950408889634f;

constexpr size_t MiB = 1u << 20;
constexpr size_t WS_W = 1 * MiB;
constexpr size_t W_FFN = 16 * MiB + MiB / 2;
constexpr size_t W_W2T = 11 * MiB;
constexpr size_t W_MIX = 33 * MiB;
constexpr size_t W_MLA_IN = 0, W_MLA_UQ = MiB + MiB / 2, W_MLA_UKV = W_MLA_UQ + MiB + MiB / 8, W_MLA_O = W_MLA_UKV + MiB;
constexpr size_t W_LRU_IN = 0, W_LRU_GATE = 4 * MiB, W_LRU_OUT = 6 * MiB;
constexpr size_t WS_R0 = 44 * MiB;
constexpr size_t WS_T = 108 * MiB;
constexpr size_t T_H = 0;
constexpr size_t T_HMLA = 0, T_QN = 0, T_QR = 64 * MiB, T_CQN = 96 * MiB, T_CKVN = 120 * MiB, T_KN = 136 * MiB, T_KR = 200 * MiB, T_V = 204 * MiB;
constexpr size_t T_GG = 0, T_P = 64 * MiB, T_XR = 64 * MiB, T_AGG = 320 * MiB;
constexpr size_t WS_END = WS_T + 332 * MiB;
constexpr int N_PHASES = 40;
#ifndef PROBE
#define PROBE 0
#endif

typedef __bf16 bf16x2_t __attribute__((ext_vector_type(2)));
__device__ __forceinline__ unsigned cvt_pk_bf16(float lo, float hi) { const f32x2 v = {lo, hi}; const bf16x2_t b = __builtin_convertvector(v, bf16x2_t); return __builtin_bit_cast(unsigned, b); }
typedef _Float16 h16x2 __attribute__((ext_vector_type(2)));
typedef _Float16 f16x8 __attribute__((ext_vector_type(8)));
__device__ __forceinline__ unsigned pk_f16(float a, float b) { h16x2 v = {(_Float16)a, (_Float16)b}; return __builtin_bit_cast(unsigned, v); }
__device__ __forceinline__ float f16_lo(unsigned w) { const h16x2 v = __builtin_bit_cast(h16x2, w); return (float)v[0]; }
__device__ __forceinline__ float f16_hi(unsigned w) { const h16x2 v = __builtin_bit_cast(h16x2, w); return (float)v[1]; }
__device__ __forceinline__ float bf_lo(unsigned w) { return __uint_as_float(w << 16); }
__device__ __forceinline__ float bf_hi(unsigned w) { return __uint_as_float(w & 0xffff0000u); }
__device__ __forceinline__ float fast_sigmoid(float x) { return __builtin_amdgcn_rcpf(1.0f + __builtin_amdgcn_exp2f(-x * LOG2E)); }
__device__ __forceinline__ float silu_f(float x) { return x * fast_sigmoid(x); }
__device__ __forceinline__ float gelu_tanh_f(float x) { const float z = 0.7978845608028654f * (x + 0.044715f * x * x * x); return x * fast_sigmoid(2.0f * z); }
__device__ __forceinline__ float wave_sum(float v) {
#pragma unroll
    for (int o = 1; o < 64; o <<= 1) v += __shfl_xor(v, o);
    return v;
}
__device__ const double INV_REV[32] = {0.15915494309189535, 0.11934937021124886, 0.08949940160889101, 0.06711508300522726, 0.050329212104487035, 0.03774158471741977, 0.0283021958306234, 0.02122365276477766,
    0.015915494309189534, 0.011934937021124886, 0.008949940160889102, 0.006711508300522725, 0.005032921210448704, 0.003774158471741977, 0.00283021958306234, 0.0021223652764777662,
    0.0015915494309189536, 0.0011934937021124885, 0.0008949940160889102, 0.0006711508300522726, 0.0005032921210448703, 0.00037741584717419774, 0.00028302195830623395, 0.0002122365276477766,
    0.00015915494309189535, 0.00011934937021124886, 8.949940160889102e-05, 6.711508300522725e-05, 5.0329212104487035e-05, 3.774158471741978e-05, 2.8302195830623396e-05, 2.122365276477766e-05};
__device__ __forceinline__ void rope_cs(int pos, int j, float& c, float& s) {
    double rev = (double)pos * INV_REV[j];
    rev -= (double)(long long)rev;
    const float f = (float)rev;
    c = __builtin_amdgcn_cosf(f); s = __builtin_amdgcn_sinf(f);
}

namespace pg8 {
constexpr int BM = 256, BK = 64, HALF = 128, HTB = HALF * BK * 2, STAGE_BYTES = 8 * HTB, NXCD = 8, WGM = 8;
__host__ __device__ __forceinline__ int lds_byte(int r, int c) { const int st = (r >> 4) * 2 + (c >> 5), rr = r & 15, cc = c & 31, ob = rr * 64 + cc * 2; return st * 1024 + (ob ^ (((ob >> 9) & 1) << 5)); }
__host__ __device__ __forceinline__ void stage_rc(int b, int& R, int& C) { const int st = b / 1024, sb = b % 1024, swz = sb ^ (((sb >> 9) & 1) << 5); R = (st >> 1) * 16 + swz / 64; C = (st & 1) * 32 + (swz % 64) / 2; }
__host__ __device__ __forceinline__ int perm32(int rho) { const int n = rho >> 4, i = rho & 15; return 8 * (i >> 2) + 4 * n + (i & 3); }

struct Unit { int pm, pn; };
struct Gemm { const bf16* A; const bf16* Bt; int lda, ldb, K; int a_sh, a_mask, a_cols; };

struct StaticOrder {
    int nM, nN, nwg, G, c;
    __device__ void init(int M_, int N_, int G_, int c_) { nM = M_ / BM; nN = N_ / BM; nwg = nM * nN; G = G_; c = c_; }
    __device__ bool next(int i, Unit& u) const {
        const long L = (long)i * G + c; if (L >= nwg) return false;
        int wgid = (int)L; { const int q = nwg / NXCD, r = nwg % NXCD, xcd = wgid % NXCD, off = wgid / NXCD; wgid = (xcd < r ? xcd * (q + 1) : r * (q + 1) + (xcd - r) * q) + off; }
        const int nig = WGM * nN, gid = wgid / nig, fm = gid * WGM, gsz = (nM - fm) < WGM ? (nM - fm) : WGM;
        u.pm = fm + ((wgid % nig) % gsz); u.pn = (wgid % nig) / gsz; return true;
    }
};

typedef f32x4 Acc[2][2][4][2];

struct EpiSwiglu {
    static constexpr bool PERM = true, FUSED = false, F16 = true;
    bf16* H; int ldh;
    __device__ __forceinline__ void operator()(const Acc& acc, const Unit& u, int wr, int wc, int fr, int fq) const {
        const int row0 = u.pm * BM + wr * 64 + fr, col = u.pn * 128 + wc * 32 + 8 * fq;
#pragma unroll
        for (int ai = 0; ai < 2; ++ai)
#pragma unroll
            for (int m = 0; m < 4; ++m) {
                bf16* p = H + (size_t)(row0 + ai * HALF + m * 16) * ldh + col;
                const f32x4 g0 = acc[ai][0][m][0], g1 = acc[ai][0][m][1], u0 = acc[ai][1][m][0], u1 = acc[ai][1][m][1];
                u32x4 w;
                w.x = cvt_pk_bf16(silu_f(g0[0]) * u0[0], silu_f(g0[1]) * u0[1]); w.y = cvt_pk_bf16(silu_f(g0[2]) * u0[2], silu_f(g0[3]) * u0[3]);
                w.z = cvt_pk_bf16(silu_f(g1[0]) * u1[0], silu_f(g1[1]) * u1[1]); w.w = cvt_pk_bf16(silu_f(g1[2]) * u1[2], silu_f(g1[3]) * u1[3]);
                *(u32x4*)p = w;
            }
    }
};
struct EpiResid {
    static constexpr bool PERM = true, FUSED = true, F16 = false;
    bf16* XN; float* Y; int wr_f32; float alpha, s; const float* lg; const float* lb;
    unsigned long long* xslots;
    unsigned tag;
    unsigned* tmo;
    __device__ __forceinline__ void fused(Acc& acc, const Unit& u, int wr, int wc, int fr, int fq, LAS unsigned char* lds, int wid, int lane) const {
        LAS f32x2* P = (LAS f32x2*)lds;
        LAS f32x2* S = (LAS f32x2*)(lds + 8192);
        const int col0 = u.pn * BM + wc * 32 + 8 * fq;
#pragma unroll
        for (int ai = 0; ai < 2; ++ai) {
#pragma unroll
            for (int m = 0; m < 4; ++m) { const size_t off = (size_t)(u.pm * BM + ai * HALF + wr * 64 + m * 16 + fr) * DM + col0;
#pragma unroll
                for (int bj = 0; bj < 2; ++bj) { const u32x4 hx = *(const u32x4*)(XN + off + bj * HALF);
                    const f32x4 x0 = {f16_lo(hx.x), f16_hi(hx.x), f16_lo(hx.y), f16_hi(hx.y)}, x1 = {f16_lo(hx.z), f16_hi(hx.z), f16_lo(hx.w), f16_hi(hx.w)};
                    acc[ai][bj][m][0] = x0 * alpha + acc[ai][bj][m][0] * s; acc[ai][bj][m][1] = x1 * alpha + acc[ai][bj][m][1] * s; }
                asm volatile("" : "+v"(acc[ai][0][m][0]), "+v"(acc[ai][0][m][1]), "+v"(acc[ai][1][m][0]), "+v"(acc[ai][1][m][1])); }
            asm volatile("" ::: "memory");
        }
        f32x4 gv[2][2], bv[2][2];
#pragma unroll
        for (int bj = 0; bj < 2; ++bj)
#pragma unroll
            for (int n = 0; n < 2; ++n) { gv[bj][n] = *(const f32x4*)(lg + col0 + bj * HALF + n * 4); bv[bj][n] = *(const f32x4*)(lb + col0 + bj * HALF + n * 4); }
#pragma unroll
        for (int ai = 0; ai < 2; ++ai)
#pragma unroll
            for (int m = 0; m < 4; ++m) {
                float sm = 0.f;
#pragma unroll
                for (int bj = 0; bj < 2; ++bj)
#pragma unroll
                    for (int n = 0; n < 2; ++n) { const f32x4 x = acc[ai][bj][m][n]; sm += (x[0] + x[1]) + (x[2] + x[3]); }
                sm += __shfl_xor(sm, 16); sm += __shfl_xor(sm, 32);
                const float mw = sm * (1.0f / 64.0f); float q = 0.f;
#pragma unroll
                for (int bj = 0; bj < 2; ++bj)
#pragma unroll
                    for (int n = 0; n < 2; ++n) { const f32x4 d = acc[ai][bj][m][n] - mw; q += (d[0] * d[0] + d[1] * d[1]) + (d[2] * d[2] + d[3] * d[3]); }
                q += __shfl_xor(q, 16); q += __shfl_xor(q, 32);
                if (fq == 0) P[(ai * HALF + wr * 64 + m * 16 + fr) * 4 + wc] = (f32x2){mw, q};
            }
        asm volatile("s_waitcnt lgkmcnt(0)" ::: "memory"); __builtin_amdgcn_s_barrier(); asm volatile("" ::: "memory");
        const int row = wid * 32 + (lane & 31);
        bool bad = false;
        if (lane < 32) {
            const f32x2 a = P[row * 4 + 0], b = P[row * 4 + 1], c = P[row * 4 + 2], d = P[row * 4 + 3];
            const float mt = (a.x + b.x + c.x + d.x) * 0.25f;
            const float da = a.x - mt, db = b.x - mt, dc = c.x - mt, dd = d.x - mt;
            const float m2 = (a.y + b.y) + (c.y + d.y) + 64.0f * ((da * da + db * db) + (dc * dc + dd * dd));
            unsigned long long* slot = xslots + (size_t)(u.pm * BM + row) * 4;
            const unsigned long long mine = ((unsigned long long)((__float_as_uint(m2) & ~31u) | tag) << 32) | __float_as_uint(mt);
            __hip_atomic_store(slot + u.pn, mine, __ATOMIC_RELAXED, __HIP_MEMORY_SCOPE_AGENT);
            unsigned long long w[4]; unsigned spins = 0;
            for (;;) {
                bool ok = true;
#pragma unroll
                for (int t = 0; t < 4; ++t) { w[t] = (t == u.pn) ? mine : __hip_atomic_load(slot + t, __ATOMIC_RELAXED, __HIP_MEMORY_SCOPE_AGENT); ok = ok && (((unsigned)(w[t] >> 32) & 31u) == tag); }
                if (ok) break;
                if (++spins > (1u << 20)) { __hip_atomic_store(tmo, 1u, __ATOMIC_RELAXED, __HIP_MEMORY_SCOPE_AGENT); bad = true; break; }
            }
            float mtv[4], m2v[4]; float ms = 0.f;
#pragma unroll
            for (int t = 0; t < 4; ++t) { mtv[t] = __uint_as_float((unsigned)w[t]); m2v[t] = __uint_as_float((unsigned)(w[t] >> 32) & ~31u); ms += mtv[t]; }
            const float mean = ms * 0.25f; float q = 0.f;
#pragma unroll
            for (int t = 0; t < 4; ++t) { const float dm = mtv[t] - mean; q += m2v[t] + 256.0f * dm * dm; }
            S[row] = (f32x2){mean, bad ? __builtin_nanf("") : 1.0f / sqrtf(q * (1.0f / 1024.0f) + LN_EPS)};
        }
        asm volatile("s_waitcnt vmcnt(0) lgkmcnt(0)" ::: "memory"); __builtin_amdgcn_s_barrier(); asm volatile("" ::: "memory");
#pragma unroll
        for (int ai = 0; ai < 2; ++ai)
#pragma unroll
            for (int m = 0; m < 4; ++m) { const int r = ai * HALF + wr * 64 + m * 16 + fr; const f32x2 sr = S[r]; const size_t off = (size_t)(u.pm * BM + r) * DM + col0;
#pragma unroll
                for (int bj = 0; bj < 2; ++bj) {
                    f32x4 o0 = (acc[ai][bj][m][0] - sr.x) * sr.y * gv[bj][0] + bv[bj][0], o1 = (acc[ai][bj][m][1] - sr.x) * sr.y * gv[bj][1] + bv[bj][1];
                    *(u32x4*)(XN + off + bj * HALF) = (u32x4){pk_f16(o0[0], o0[1]), pk_f16(o0[2], o0[3]), pk_f16(o1[0], o1[1]), pk_f16(o1[2], o1[3])};
                    if (wr_f32) { *(f32x4*)(Y + off + bj * HALF) = o0; *(f32x4*)(Y + off + bj * HALF + 4) = o1; } } }
    }
};
__device__ __forceinline__ u32x4 pack8(const f32x4 a, const f32x4 b) { u32x4 w; w.x = cvt_pk_bf16(a[0], a[1]); w.y = cvt_pk_bf16(a[2], a[3]); w.z = cvt_pk_bf16(b[0], b[1]); w.w = cvt_pk_bf16(b[2], b[3]); return w; }
struct EpiMlaIn {
    static constexpr bool PERM = true, FUSED = false, F16 = true;
    bf16* CQ; bf16* CKV; bf16* KR; float* stat; const int* pos;
    __device__ __forceinline__ void operator()(const Acc& acc, const Unit& u, int wr, int wc, int fr, int fq) const {
        const int row0 = u.pm * BM + wr * 64 + fr, lc = wc * 32 + 8 * fq;
#pragma unroll
        for (int ai = 0; ai < 2; ++ai)
#pragma unroll
            for (int m = 0; m < 4; ++m) { const int row = row0 + ai * HALF + m * 16;
#pragma unroll
                for (int bj = 0; bj < 2; ++bj) { const int seg = u.pn * 2 + bj; const f32x4 v0 = acc[ai][bj][m][0], v1 = acc[ai][bj][m][1];
                    if (seg < 5) {
                        float ss = (v0[0] * v0[0] + v0[1] * v0[1]) + (v0[2] * v0[2] + v0[3] * v0[3]) + (v1[0] * v1[0] + v1[1] * v1[1]) + (v1[2] * v1[2] + v1[3] * v1[3]);
                        ss += __shfl_xor(ss, 16); ss += __shfl_xor(ss, 32);
                        if (fq == 0) atomicAdd(stat + (size_t)row * 2 + (seg >= 3 ? 1 : 0), ss);
                        bf16* dst = (seg < 3) ? CQ + (size_t)row * QLR + seg * 128 + lc : CKV + (size_t)row * KVLR + (seg - 3) * 128 + lc;
                        *(u32x4*)dst = pack8(v0, v1);
                    } else if (wc < 2) {
                        const int jj0 = 16 * wc + 4 * fq; const int ps = pos[row]; f32x4 o1, o2;
#pragma unroll
                        for (int e = 0; e < 4; ++e) { float c, sn; rope_cs(ps, jj0 + e, c, sn); o1[e] = v0[e] * c - v1[e] * sn; o2[e] = v1[e] * c + v0[e] * sn; }
                        *(u32x2*)(KR + (size_t)row * 64 + jj0) = (u32x2){cvt_pk_bf16(o1[0], o1[1]), cvt_pk_bf16(o1[2], o1[3])};
                        *(u32x2*)(KR + (size_t)row * 64 + 32 + jj0) = (u32x2){cvt_pk_bf16(o2[0], o2[1]), cvt_pk_bf16(o2[2], o2[3])};
                    } } }
    }
};
struct EpiQ {
    static constexpr bool PERM = true, FUSED = false, F16 = false;
    bf16* Qn; bf16* Qr; const int* pos; const float* stat;
    __device__ __forceinline__ void operator()(const Acc& acc, const Unit& u, int wr, int wc, int fr, int fq) const {
        const int row0 = u.pm * BM + wr * 64 + fr;
        if (u.pn < 4) {
            const int col = u.pn * BM + wc * 32 + 8 * fq;
#pragma unroll
            for (int ai = 0; ai < 2; ++ai)
#pragma unroll
                for (int m = 0; m < 4; ++m) { const int row = row0 + ai * HALF + m * 16; bf16* p = Qn + (size_t)row * DM + col;
                    const float sc = QSCALE / sqrtf(stat[(size_t)row * 2] * (1.f / QLR) + RMS_EPS);
#pragma unroll
                    for (int bj = 0; bj < 2; ++bj) *(u32x4*)(p + bj * HALF) = pack8(acc[ai][bj][m][0] * sc, acc[ai][bj][m][1] * sc); }
        } else {
            const int head = 4 * (u.pn - 4) + wc, j0 = 8 * fq;
#pragma unroll
            for (int ai = 0; ai < 2; ++ai)
#pragma unroll
                for (int m = 0; m < 4; ++m) {
                    const int row = row0 + ai * HALF + m * 16; const int ps = pos[row];
                    const float sc = QSCALE / sqrtf(stat[(size_t)row * 2] * (1.f / QLR) + RMS_EPS);
                    f32x4 o1[2], o2[2];
#pragma unroll
                    for (int n = 0; n < 2; ++n)
#pragma unroll
                        for (int e = 0; e < 4; ++e) { float c, s; rope_cs(ps, j0 + 4 * n + e, c, s); const float t1 = acc[ai][0][m][n][e], t2 = acc[ai][1][m][n][e];
                            o1[n][e] = (t1 * c - t2 * s) * sc; o2[n][e] = (t2 * c + t1 * s) * sc; }
                    bf16* p = Qr + (size_t)row * 512 + head * 64 + j0;
                    *(u32x4*)p = pack8(o1[0], o1[1]); *(u32x4*)(p + 32) = pack8(o2[0], o2[1]);
                }
        }
    }
};
struct EpiKV {
    static constexpr bool PERM = true, FUSED = false, F16 = false;
    bf16* Kn; bf16* V; const float* stat;
    __device__ __forceinline__ void operator()(const Acc& acc, const Unit& u, int wr, int wc, int fr, int fq) const {
        const int row0 = u.pm * BM + wr * 64 + fr, col = u.pn * 128 + wc * 32 + 8 * fq;
#pragma unroll
        for (int ai = 0; ai < 2; ++ai)
#pragma unroll
            for (int m = 0; m < 4; ++m) { const int row = row0 + ai * HALF + m * 16; const size_t off = (size_t)row * DM + col;
                const float sc = 1.0f / sqrtf(stat[(size_t)row * 2 + 1] * (1.f / KVLR) + RMS_EPS);
                *(u32x4*)(Kn + off) = pack8(acc[ai][0][m][0] * sc, acc[ai][0][m][1] * sc); *(u32x4*)(V + off) = pack8(acc[ai][1][m][0] * sc, acc[ai][1][m][1] * sc); }
    }
};
struct EpiLruIn {
    static constexpr bool PERM = true, FUSED = false, F16 = true;
    bf16* GG; bf16* XR;
    __device__ __forceinline__ void operator()(const Acc& acc, const Unit& u, int wr, int wc, int fr, int fq) const {
        const int row0 = u.pm * BM + wr * 64 + fr; const bool isg = u.pn < 4; const int col = (u.pn & 3) * BM + wc * 32 + 8 * fq; bf16* base = isg ? GG : XR;
#pragma unroll
        for (int ai = 0; ai < 2; ++ai)
#pragma unroll
            for (int m = 0; m < 4; ++m) { bf16* p = base + (size_t)(row0 + ai * HALF + m * 16) * DM + col;
#pragma unroll
                for (int bj = 0; bj < 2; ++bj) { f32x4 a = acc[ai][bj][m][0], b = acc[ai][bj][m][1];
                    if (isg) {
#pragma unroll
                        for (int e = 0; e < 4; ++e) { a[e] = gelu_tanh_f(a[e]); b[e] = gelu_tanh_f(b[e]); } }
                    *(u32x4*)(p + bj * HALF) = pack8(a, b); } }
    }
};
struct EpiGate {
    static constexpr bool PERM = true, FUSED = false, F16 = false;
    unsigned* P; const bf16* XC; const float* gate_b; const float* lam;
    __device__ __forceinline__ void operator()(const Acc& acc, const Unit& u, int wr, int wc, int fr, int fq) const {
        const int dir = u.pn >> 3, nb = (u.pn >> 1) & 3, hd = u.pn & 1;
        const int row0 = u.pm * BM + wr * 64 + fr, ch0 = nb * 256 + hd * 128 + wc * 32 + 8 * fq;
        float br[8], bi[8], ls[8];
#pragma unroll
        for (int e = 0; e < 8; ++e) { br[e] = gate_b[(2 * dir) * DM + ch0 + e]; bi[e] = gate_b[(2 * dir + 1) * DM + ch0 + e];
            ls[e] = lam[dir * DM + ch0 + e]; }
        unsigned* Pd = P + (size_t)dir * M * DM;
#pragma unroll
        for (int ai = 0; ai < 2; ++ai)
#pragma unroll
            for (int m = 0; m < 4; ++m) {
                const size_t off = (size_t)(row0 + ai * HALF + m * 16) * DM + ch0;
                const u32x4 xw = *(const u32x4*)(XC + off);
                unsigned w[8];
#pragma unroll
                for (int e = 0; e < 8; ++e) {
                    const float r = fast_sigmoid(acc[ai][0][m][e >> 2][e & 3] + br[e]), ig = fast_sigmoid(acc[ai][1][m][e >> 2][e & 3] + bi[e]);
                    const unsigned xww = xw[e >> 1]; const float xc = (e & 1) ? bf_hi(xww) : bf_lo(xww);
                    const float la2 = r * ls[e]; const float a2 = __builtin_amdgcn_exp2f(2.0f * la2);
                    const float uu = __builtin_amdgcn_sqrtf(fmaxf(1.0f - a2, 0.0f)) * ig * xc;
                    w[e] = cvt_pk_bf16(la2, uu);
                }
                *(u32x4*)(Pd + off) = (u32x4){w[0], w[1], w[2], w[3]}; *(u32x4*)(Pd + off + 4) = (u32x4){w[4], w[5], w[6], w[7]};
            }
    }
};

template <class Epi>
__device__ __forceinline__ void gemm_phase(LAS unsigned char* lds, const Gemm g, const StaticOrder& S, const Epi& E) {
    int tid_ = threadIdx.x; asm volatile("" : "+v"(tid_));
    const int tid = tid_, wid = __builtin_amdgcn_readfirstlane(tid >> 6), lane = tid & 63, wr = wid >> 2, wc = wid & 3, fr = lane & 15, fq = lane >> 4;
    int K_ = g.K; asm volatile("" : "+s"(K_));
    const int K = K_, nt = K / BK;
    unsigned voffA[2], voffB[2];
#pragma unroll
    for (int i = 0; i < 2; ++i) { int R, C; stage_rc(tid * 16 + i * 8192, R, C); const int Rb = Epi::PERM ? ((R & ~31) + perm32(R & 31)) : R;
        voffA[i] = (unsigned)(R * g.lda + C) * 2u; voffB[i] = (unsigned)(Rb * g.ldb + C) * 2u; }
    const size_t kstep = (size_t)(BK * 2);
    const size_t hstepA = (size_t)HALF * g.lda * 2, hstepB = (size_t)HALF * g.ldb * 2;
    const unsigned ldsw = (unsigned)wid * 1024u;
    const int aoff = lds_byte(wr * 64 + fr, fq * 8), boff = lds_byte(wc * 32 + fr, fq * 8);
#define PG8_UA(u) ((const char*)g.A + (size_t)(u).pm * 2 * hstepA + (size_t)((((u).pn >> g.a_sh) & g.a_mask) * g.a_cols) * 2)
#define PG8_UB(u) ((const char*)g.Bt + (size_t)(u).pn * 2 * hstepB)
#define PG8_SA(b, h) (((b) * 2 + (h)) * HTB)
#define PG8_SB(b, h) ((4 + (b) * 2 + (h)) * HTB)
#define PG8_STAGE(bufoff, gbase, voff) do { _Pragma("unroll") for (int _i = 0; _i < 2; ++_i) \
        __builtin_amdgcn_global_load_lds((const unsigned*)((const char*)(gbase) + (voff)[_i]), (LAS unsigned*)(lds + (bufoff) + ldsw + _i * 8192), 16, 0, 0); } while (0)
#define PG8_LDA(dst, b, h) do { _Pragma("unroll") for (int m = 0; m < 4; ++m) _Pragma("unroll") for (int k = 0; k < 2; ++k) dst[m][k] = *(const LAS bf16x8*)(lds + PG8_SA(b, h) + aoff + m * 2048 + k * 1024); } while (0)
#define PG8_LDB(dst, b, h) do { _Pragma("unroll") for (int n = 0; n < 2; ++n) _Pragma("unroll") for (int k = 0; k < 2; ++k) dst[n][k] = *(const LAS bf16x8*)(lds + PG8_SB(b, h) + boff + n * 2048 + k * 1024); } while (0)
#define PG8_MMA(ai, bj, At, Bt) do { __builtin_amdgcn_s_setprio(1); _Pragma("unroll") for (int m = 0; m < 4; ++m) _Pragma("unroll") for (int n = 0; n < 2; ++n) _Pragma("unroll") for (int k = 0; k < 2; ++k) \
        { if constexpr (Epi::F16) acc[ai][bj][m][n] = __builtin_amdgcn_mfma_f32_16x16x32_f16(__builtin_bit_cast(f16x8, Bt[n][k]), __builtin_bit_cast(f16x8, At[m][k]), acc[ai][bj][m][n], 0, 0, 0); \
          else acc[ai][bj][m][n] = __builtin_amdgcn_mfma_f32_16x16x32_bf16(Bt[n][k], At[m][k], acc[ai][bj][m][n], 0, 0, 0); } __builtin_amdgcn_s_setprio(0); } while (0)
#define PG8_WAIT_V(n) asm volatile("s_waitcnt vmcnt(" #n ")" ::: "memory")
#define PG8_WAIT_L(n) asm volatile("s_waitcnt lgkmcnt(" #n ")" ::: "memory")
#define PG8_BAR __builtin_amdgcn_s_barrier()
#define PG8_SCHED __builtin_amdgcn_sched_barrier(0)
    Unit cur, nxt; int ui = 0;
    if (!S.next(0, cur)) return;
    Acc acc;
#pragma unroll
    for (int a = 0; a < 2; ++a)
#pragma unroll
        for (int b = 0; b < 2; ++b)
#pragma unroll
            for (int m = 0; m < 4; ++m)
#pragma unroll
                for (int n = 0; n < 2; ++n) acc[a][b][m][n] = (f32x4){0.f, 0.f, 0.f, 0.f};
    bf16x8 At[4][2], B0[2][2], B1[2][2];
    const char* cA = PG8_UA(cur); const char* cB = PG8_UB(cur);
    PG8_STAGE(PG8_SB(0, 0), cB, voffB); PG8_STAGE(PG8_SB(0, 1), cB + hstepB, voffB); PG8_STAGE(PG8_SA(0, 0), cA, voffA); PG8_STAGE(PG8_SA(0, 1), cA + hstepA, voffA);
    PG8_STAGE(PG8_SB(1, 0), cB + kstep, voffB); PG8_STAGE(PG8_SA(1, 0), cA + kstep, voffA); PG8_STAGE(PG8_SB(1, 1), cB + hstepB + kstep, voffB);
    if (wr == 1) PG8_BAR;
    PG8_WAIT_V(8); PG8_BAR;
    PG8_WAIT_V(6); PG8_BAR;
    for (;;) {
        const bool has_next = S.next(ui + 1, nxt);
        const char* nA = has_next ? PG8_UA(nxt) : cA; const char* nB = has_next ? PG8_UB(nxt) : cB;
        for (int t = 0; t < nt; t += 2) {
            const bool last = (t == nt - 2);
            const char* a1 = cA + (size_t)(t + 1) * kstep;
            const char* a2 = last ? nA : cA + (size_t)(t + 2) * kstep; const char* b2 = last ? nB : cB + (size_t)(t + 2) * kstep;
            const char* a3 = a2 + kstep; const char* b3 = b2 + kstep;
            PG8_LDB(B0, 0, 0); PG8_LDB(B1, 0, 1); PG8_SCHED; PG8_LDA(At, 0, 0); PG8_STAGE(PG8_SA(1, 1), a1 + hstepA, voffA);
            PG8_WAIT_V(8); PG8_WAIT_L(0); PG8_BAR; PG8_MMA(0, 0, At, B0); PG8_MMA(0, 1, At, B1); PG8_BAR; PG8_SCHED;
            PG8_LDA(At, 0, 1); PG8_STAGE(PG8_SB(0, 0), b2, voffB); PG8_STAGE(PG8_SB(0, 1), b2 + hstepB, voffB); PG8_STAGE(PG8_SA(0, 0), a2, voffA);
            PG8_WAIT_V(8); PG8_WAIT_L(0); PG8_BAR; PG8_MMA(1, 0, At, B0); PG8_MMA(1, 1, At, B1); PG8_BAR; PG8_SCHED;
            PG8_LDB(B0, 1, 0); PG8_LDB(B1, 1, 1); PG8_SCHED; PG8_LDA(At, 1, 0); PG8_STAGE(PG8_SA(0, 1), a2 + hstepA, voffA);
            PG8_WAIT_V(8); PG8_WAIT_L(0); PG8_BAR; PG8_MMA(0, 0, At, B0); PG8_MMA(0, 1, At, B1); PG8_BAR; PG8_SCHED;
            PG8_LDA(At, 1, 1); PG8_STAGE(PG8_SB(1, 0), b3, voffB); PG8_STAGE(PG8_SB(1, 1), b3 + hstepB, voffB); PG8_STAGE(PG8_SA(1, 0), a3, voffA);
            PG8_WAIT_V(8); PG8_WAIT_L(0); PG8_BAR; PG8_MMA(1, 0, At, B0); PG8_MMA(1, 1, At, B1); PG8_BAR; PG8_SCHED;
        }
        if (wr == 0) PG8_BAR;
        if constexpr (Epi::FUSED) E.fused(acc, cur, wr, wc, fr, fq, lds + STAGE_BYTES, wid, lane); else E(acc, cur, wr, wc, fr, fq);
        if (!has_next) break;
#pragma unroll
        for (int a = 0; a < 2; ++a)
#pragma unroll
            for (int b = 0; b < 2; ++b)
#pragma unroll
                for (int m = 0; m < 4; ++m)
#pragma unroll
                    for (int n = 0; n < 2; ++n) acc[a][b][m][n] = (f32x4){0.f, 0.f, 0.f, 0.f};
        cur = nxt; cA = nA; cB = nB; ++ui;
        if (wr == 1) PG8_BAR;
    }
    PG8_WAIT_V(0);
    PG8_BAR;
#undef PG8_UA
#undef PG8_UB
#undef PG8_SA
#undef PG8_SB
#undef PG8_STAGE
#undef PG8_LDA
#undef PG8_LDB
#undef PG8_MMA
#undef PG8_WAIT_V
#undef PG8_WAIT_L
#undef PG8_BAR
#undef PG8_SCHED
}
}

namespace attn {
constexpr int NW = 8, QBLK = 32, KVBLK = 64, KROW = 400;
constexpr int SHM_V = KVBLK * 128 * 2, SHM_K = KVBLK * KROW, SHM_ATTN = 2 * SHM_V + 2 * SHM_K + NW * 64 * 4;
#define SBAR() __builtin_amdgcn_sched_barrier(0)
__device__ __forceinline__ int crow(int r, int hi) { return (r & 3) + 8 * (r >> 2) + 4 * hi; }
__device__ __forceinline__ void partialSM(f32x16& p0, f32x16& p1, float& m_reg, float& mn, float& alpha) {
    float pmax = p0[0];
#pragma unroll
    for (int r = 1; r < 16; ++r) pmax = fmaxf(pmax, p0[r]);
#pragma unroll
    for (int r = 0; r < 16; ++r) pmax = fmaxf(pmax, p1[r]);
    { auto rr = __builtin_amdgcn_permlane32_swap(__float_as_uint(pmax), __float_as_uint(pmax), false, false);
      pmax = fmaxf(__uint_as_float(rr[0]), __uint_as_float(rr[1])); }
    if (__builtin_expect(__all(pmax - m_reg <= THR2), 1)) { mn = m_reg; alpha = 1.f; }
    else { mn = fmaxf(m_reg, pmax); alpha = __builtin_amdgcn_exp2f(m_reg - mn); m_reg = mn; }
#pragma unroll
    for (int r = 0; r < 16; ++r) p0[r] = p0[r] - mn;
#pragma unroll
    for (int r = 0; r < 16; ++r) p1[r] = p1[r] - mn;
#pragma unroll
    for (int r = 0; r < 16; ++r) p0[r] = __builtin_amdgcn_exp2f(p0[r]);
}
__device__ __forceinline__ void sm_decide(float pmax, float& m_reg, float& mn, float& alpha) {
    { auto rr = __builtin_amdgcn_permlane32_swap(__float_as_uint(pmax), __float_as_uint(pmax), false, false);
      pmax = fmaxf(__uint_as_float(rr[0]), __uint_as_float(rr[1])); }
    if (__builtin_expect(__all(pmax - m_reg <= THR2), 1)) { mn = m_reg; alpha = 1.f; }
    else { mn = fmaxf(m_reg, pmax); alpha = __builtin_amdgcn_exp2f(m_reg - mn); m_reg = mn; }
}
__device__ __forceinline__ void sm_tail(f32x16& p0, f32x16& p1, float mn) {
#pragma unroll
    for (int r = 0; r < 16; ++r) p0[r] = p0[r] - mn;
#pragma unroll
    for (int r = 0; r < 16; ++r) p1[r] = p1[r] - mn;
#pragma unroll
    for (int r = 0; r < 16; ++r) p0[r] = __builtin_amdgcn_exp2f(p0[r]);
}
__device__ __forceinline__ void finishSM(f32x16& p0, f32x16& p1, float alpha, float& l_reg, bf16x8& pa0, bf16x8& pa1, bf16x8& pa2, bf16x8& pa3) {
#pragma unroll
    for (int r = 0; r < 16; ++r) p1[r] = __builtin_amdgcn_exp2f(p1[r]);
    float ps = 0;
#pragma unroll
    for (int r = 0; r < 16; ++r) ps += p0[r];
#pragma unroll
    for (int r = 0; r < 16; ++r) ps += p1[r];
    { auto rr = __builtin_amdgcn_permlane32_swap(__float_as_uint(ps), __float_as_uint(ps), false, false);
      ps = __uint_as_float(rr[0]) + __uint_as_float(rr[1]); }
    l_reg = l_reg * alpha + ps;
#define PK4(P, BASE, OUT) do { unsigned a0 = cvt_pk_bf16(P[BASE + 0], P[BASE + 1]), a1 = cvt_pk_bf16(P[BASE + 2], P[BASE + 3]);   \
    unsigned b0 = cvt_pk_bf16(P[BASE + 4], P[BASE + 5]), b1 = cvt_pk_bf16(P[BASE + 6], P[BASE + 7]);                              \
    auto r0 = __builtin_amdgcn_permlane32_swap(a0, b0, false, false); auto r1 = __builtin_amdgcn_permlane32_swap(a1, b1, false, false); \
    u32x4 w = {r0[0], r1[0], r0[1], r1[1]}; OUT = *reinterpret_cast<bf16x8*>(&w); } while (0)
    PK4(p0, 0, pa0); PK4(p0, 8, pa1); PK4(p1, 0, pa2); PK4(p1, 8, pa3);
#undef PK4
}
__device__ __forceinline__ void qkt(f32x16& p0, f32x16& p1, const char* Ks, const bf16x8* qr, int r32, int hi) {
    p0 = f32x16{}; p1 = f32x16{};
#pragma unroll
    for (int d0 = 0; d0 < 12; ++d0) { const int cb = (d0 * 16 + hi * 8) * 2;
        const bf16x8 b0 = *reinterpret_cast<const bf16x8*>(Ks + r32 * KROW + cb);
        const bf16x8 b1 = *reinterpret_cast<const bf16x8*>(Ks + (32 + r32) * KROW + cb);
        p0 = __builtin_amdgcn_mfma_f32_32x32x16_bf16(b0, qr[d0], p0, 0, 0, 0);
        p1 = __builtin_amdgcn_mfma_f32_32x32x16_bf16(b1, qr[d0], p1, 0, 0, 0); }
}
__device__ __forceinline__ int v_st(int k, int c) { const int kk = (k & ~0xC) | ((k & 4) << 1) | ((k & 8) >> 1); return ((kk >> 3) * 4 + (c >> 5)) * 512 + ((kk & 7) * 32 + (c & 31)) * 2; }
__device__ __forceinline__ int v_rd_base(int lane) { return ((lane & 3) << 3) | (((lane >> 2) & 3) << 6) | (((lane >> 4) & 1) << 5) | (((lane >> 5) & 1) << 8); }
constexpr int v_rd_off(int d0, int ks, int half) { return d0 * 512 + ks * 4096 + half * 2048; }
template <int OFF> __device__ __forceinline__ s16x4 tr_read(int vb) {
    s16x4 r; asm volatile("ds_read_b64_tr_b16 %0, %1 offset:%2" : "=&v"(r) : "v"(vb), "i"(OFF) : "memory"); return r;
}
template <int D0> __device__ __forceinline__ void pv_one(f32x16& od, int vb, bf16x8 pa0, bf16x8 pa1, bf16x8 pa2, bf16x8 pa3) {
    const s16x4 l0 = tr_read<v_rd_off(D0, 0, 0)>(vb), h0 = tr_read<v_rd_off(D0, 0, 1)>(vb), l1 = tr_read<v_rd_off(D0, 1, 0)>(vb), h1 = tr_read<v_rd_off(D0, 1, 1)>(vb);
    const s16x4 l2 = tr_read<v_rd_off(D0, 2, 0)>(vb), h2 = tr_read<v_rd_off(D0, 2, 1)>(vb), l3 = tr_read<v_rd_off(D0, 3, 0)>(vb), h3 = tr_read<v_rd_off(D0, 3, 1)>(vb);
    asm volatile("s_waitcnt lgkmcnt(0)" ::: "memory"); SBAR();
#define PK(L, H) (bf16x8){L[0], L[1], L[2], L[3], H[0], H[1], H[2], H[3]}
    od = __builtin_amdgcn_mfma_f32_32x32x16_bf16(pa0, PK(l0, h0), od, 0, 0, 0);
    od = __builtin_amdgcn_mfma_f32_32x32x16_bf16(pa1, PK(l1, h1), od, 0, 0, 0);
    od = __builtin_amdgcn_mfma_f32_32x32x16_bf16(pa2, PK(l2, h2), od, 0, 0, 0);
    od = __builtin_amdgcn_mfma_f32_32x32x16_bf16(pa3, PK(l3, h3), od, 0, 0, 0);
#undef PK
}
template <int D0> __device__ __forceinline__ void pv_one_sm(f32x16& od, int vb, bf16x8 pa0, bf16x8 pa1, bf16x8 pa2, bf16x8 pa3, const f32x16& q0, const f32x16& q1, float& pmax) {
    const s16x4 l0 = tr_read<v_rd_off(D0, 0, 0)>(vb), h0 = tr_read<v_rd_off(D0, 0, 1)>(vb), l1 = tr_read<v_rd_off(D0, 1, 0)>(vb), h1 = tr_read<v_rd_off(D0, 1, 1)>(vb);
    const s16x4 l2 = tr_read<v_rd_off(D0, 2, 0)>(vb), h2 = tr_read<v_rd_off(D0, 2, 1)>(vb), l3 = tr_read<v_rd_off(D0, 3, 0)>(vb), h3 = tr_read<v_rd_off(D0, 3, 1)>(vb);
    {   const f32x16& q = (D0 < 2) ? q0 : q1; constexpr int B = (D0 & 1) * 8;
        float m = (D0 == 0) ? q[0] : pmax;
#pragma unroll
        for (int r = (D0 == 0) ? 1 : 0; r < 8; ++r) m = fmaxf(m, q[B + r]);
        pmax = m; }
    asm volatile("s_waitcnt lgkmcnt(0)" ::: "memory"); SBAR();
#define PK(L, H) (bf16x8){L[0], L[1], L[2], L[3], H[0], H[1], H[2], H[3]}
    od = __builtin_amdgcn_mfma_f32_32x32x16_bf16(pa0, PK(l0, h0), od, 0, 0, 0);
    od = __builtin_amdgcn_mfma_f32_32x32x16_bf16(pa1, PK(l1, h1), od, 0, 0, 0);
    od = __builtin_amdgcn_mfma_f32_32x32x16_bf16(pa2, PK(l2, h2), od, 0, 0, 0);
    od = __builtin_amdgcn_mfma_f32_32x32x16_bf16(pa3, PK(l3, h3), od, 0, 0, 0);
#undef PK
}
__device__ __forceinline__ void pv_sm(f32x16* o, int vb, bf16x8 pa0, bf16x8 pa1, bf16x8 pa2, bf16x8 pa3, const f32x16& q0, const f32x16& q1, float& pmax) {
    pv_one_sm<0>(o[0], vb, pa0, pa1, pa2, pa3, q0, q1, pmax); pv_one_sm<1>(o[1], vb, pa0, pa1, pa2, pa3, q0, q1, pmax);
    pv_one_sm<2>(o[2], vb, pa0, pa1, pa2, pa3, q0, q1, pmax); pv_one_sm<3>(o[3], vb, pa0, pa1, pa2, pa3, q0, q1, pmax);
}
__device__ __forceinline__ void pv_d0(f32x16* o, int vb, bf16x8 pa0, bf16x8 pa1, bf16x8 pa2, bf16x8 pa3) {
    pv_one<0>(o[0], vb, pa0, pa1, pa2, pa3); pv_one<1>(o[1], vb, pa0, pa1, pa2, pa3); pv_one<2>(o[2], vb, pa0, pa1, pa2, pa3); pv_one<3>(o[3], vb, pa0, pa1, pa2, pa3);
}
__device__ __forceinline__ void attn_unit(long rowb, int h, int q0, const bf16* Qn, const bf16* Qr, const bf16* __restrict__ Kn, const bf16* __restrict__ Kr, const bf16* __restrict__ Vv, bf16* O, char* lds) {
    int tid_ = threadIdx.x; asm volatile("" : "+v"(tid_));
    const int tid = tid_, wid = tid >> 6, lane = tid & 63, r32 = lane & 31, hi = lane >> 5;
    char* V_lds = lds; char* K_lds = lds + 2 * SHM_V;
    float* ws = (float*)(lds + 2 * SHM_V + 2 * SHM_K) + wid * 64; float* li_l = ws; float* al_l = ws + 32;
    float m_reg = -1e30f, l_reg = 0; f32x16 o[4] = {}; bf16x8 qr[12];
    const long qrow = rowb + q0 + wid * QBLK + r32;
#pragma unroll
    for (int d0 = 0; d0 < 8; ++d0) qr[d0] = *reinterpret_cast<const bf16x8*>(Qn + qrow * DM + h * 128 + d0 * 16 + hi * 8);
#pragma unroll
    for (int d0 = 0; d0 < 4; ++d0) qr[8 + d0] = *reinterpret_cast<const bf16x8*>(Qr + qrow * 512 + h * 64 + d0 * 16 + hi * 8);
    const int sr = tid >> 4, sc = (tid & 15) * 8, vst0 = v_st(sr, sc), vst1 = v_st(32 + sr, sc);
    const int ksr = tid >> 3, ksub = tid & 7;
    const int vb0 = (int)(uintptr_t)V_lds + v_rd_base(lane);
    const bf16* Vh = Vv + rowb * DM + h * 128; const bf16* Knh = Kn + rowb * DM + h * 128; const bf16* Krh = Kr + rowb * 64;
    bf16x8 vs0, vs1, ks0, ks1, ks2;
#define SLOAD(k0) do { vs0 = *(const bf16x8*)(Vh + (long)((k0) + sr) * DM + sc); vs1 = *(const bf16x8*)(Vh + (long)((k0) + 32 + sr) * DM + sc); \
    ks0 = *(const bf16x8*)(Knh + (long)((k0) + ksr) * DM + ksub * 8); ks1 = *(const bf16x8*)(Knh + (long)((k0) + ksr) * DM + 64 + ksub * 8); \
    ks2 = *(const bf16x8*)(Krh + (long)((k0) + ksr) * 64 + ksub * 8); } while (0)
#define SWRITE(b) do { *(bf16x8*)(V_lds + (b) * SHM_V + vst0) = vs0; *(bf16x8*)(V_lds + (b) * SHM_V + vst1) = vs1; \
    *(bf16x8*)(K_lds + (b) * SHM_K + ksr * KROW + ksub * 16) = ks0; *(bf16x8*)(K_lds + (b) * SHM_K + ksr * KROW + 128 + ksub * 16) = ks1; \
    *(bf16x8*)(K_lds + (b) * SHM_K + ksr * KROW + 256 + ksub * 16) = ks2; } while (0)
#define SWAIT() asm volatile("s_waitcnt vmcnt(0)" ::: "memory")
#define RESC(a) do { if (__any((a) < 1.f)) { if (hi == 0) al_l[r32] = (a); asm volatile("s_waitcnt lgkmcnt(0)" ::: "memory"); \
    _Pragma("unroll") for (int d = 0; d < 4; ++d) _Pragma("unroll") for (int r = 0; r < 16; ++r) o[d][r] *= al_l[crow(r, hi)]; } } while (0)
    f32x16 pA0, pA1, pB0, pB1; float mnA, mnB, alA, alB; bf16x8 pa0, pa1, pa2, pa3; constexpr int NT = SEQ / KVBLK;
    float pmx;
    if (__builtin_amdgcn_readfirstlane(tid) >= 256) __builtin_amdgcn_s_setprio(1);
    SLOAD(0); SWAIT(); SWRITE(0); SLOAD(KVBLK); __syncthreads();
    qkt(pA0, pA1, K_lds, qr, r32, hi);
    { pmx = pA0[0];
#pragma unroll
      for (int r = 1; r < 16; ++r) pmx = fmaxf(pmx, pA0[r]);
#pragma unroll
      for (int r = 0; r < 16; ++r) pmx = fmaxf(pmx, pA1[r]);
      sm_decide(pmx, m_reg, mnA, alA); }
    SWAIT(); SWRITE(1); __syncthreads();
    for (int j = 1; j + 1 < NT; j += 2) {
        SBAR(); qkt(pB0, pB1, K_lds + SHM_K, qr, r32, hi);
        sm_tail(pA0, pA1, mnA); finishSM(pA0, pA1, alA, l_reg, pa0, pa1, pa2, pa3); SBAR();
        SLOAD((j + 1) * KVBLK); SBAR();
        pv_sm(o, vb0, pa0, pa1, pa2, pa3, pB0, pB1, pmx); sm_decide(pmx, m_reg, mnB, alB);
        __syncthreads(); SWAIT(); SWRITE(0);
        RESC(alB); __syncthreads();
        SBAR(); qkt(pA0, pA1, K_lds, qr, r32, hi);
        sm_tail(pB0, pB1, mnB); finishSM(pB0, pB1, alB, l_reg, pa0, pa1, pa2, pa3); SBAR();
        SLOAD((j + 2) * KVBLK); SBAR();
        pv_sm(o, vb0 + SHM_V, pa0, pa1, pa2, pa3, pA0, pA1, pmx); sm_decide(pmx, m_reg, mnA, alA);
        __syncthreads(); SWAIT(); SWRITE(1);
        RESC(alA); __syncthreads();
    }
    SBAR(); qkt(pB0, pB1, K_lds + SHM_K, qr, r32, hi);
    sm_tail(pA0, pA1, mnA); finishSM(pA0, pA1, alA, l_reg, pa0, pa1, pa2, pa3); SBAR();
    pv_sm(o, vb0, pa0, pa1, pa2, pa3, pB0, pB1, pmx); sm_decide(pmx, m_reg, mnB, alB);
    __syncthreads(); RESC(alB);
    sm_tail(pB0, pB1, mnB); finishSM(pB0, pB1, alB, l_reg, pa0, pa1, pa2, pa3); SBAR();
    pv_d0(o, vb0 + SHM_V, pa0, pa1, pa2, pa3);
    __builtin_amdgcn_s_setprio(0);
    if (hi == 0) li_l[r32] = l_reg; asm volatile("s_waitcnt lgkmcnt(0)" ::: "memory");
    float rli[16];
#pragma unroll
    for (int r = 0; r < 16; ++r) rli[r] = __builtin_amdgcn_rcpf(li_l[crow(r, hi)]);
    bf16* Ow = O + (rowb + q0 + wid * QBLK) * DM + h * 128;
#pragma unroll
    for (int r = 0; r < 16; ++r) { const int orow = crow(r, hi);
#pragma unroll
        for (int d0 = 0; d0 < 4; ++d0) { const unsigned w = cvt_pk_bf16(o[d0][r] * rli[r], 0.f); Ow[(long)orow * DM + d0 * 32 + r32] = (bf16)(w & 0xffffu); } }
    __syncthreads();
#undef SLOAD
#undef SWRITE
#undef SWAIT
#undef RESC
}
#undef SBAR
}

__device__ __forceinline__ int rowmap(int mode, int n0) {
    if (mode == 0) return n0;
    if (mode == 1) return ((n0 >> 7) << 8) + (n0 & 127);
    if (mode == 2) return ((n0 >> 7) << 8) + 128 + (n0 & 127);
    if (mode == 4) { if (n0 < 640) return n0; const int c = n0 - 640, n = c >> 5, jj = c & 31; return 640 + 32 * (jj >> 4) + 8 * ((jj >> 2) & 3) + 4 * n + (jj & 3); }
    const int h = n0 / 192, d = n0 - h * 192;
    if (d < 128) return h * 128 + d;
    const int jj = d - 128;
    return 1024 + 256 * (h >> 2) + 128 * (jj >> 5) + 32 * (h & 3) + (jj & 31);
}
__device__ __forceinline__ void cvt_job(const float* W, int K, int N, bf16* WT, int mode, LAS float* scr, int gw, int NGW, int lane, int rot, bool f16 = false, const float* kscale = nullptr) {
    asm volatile("" : "+v"(lane));
    const int nblk = N / 32, nitems = (K / 64) * nblk;
    int start = gw - (rot % NGW); if (start < 0) start += NGW;
    for (int it = start; it < nitems; it += NGW) {
        const int kb = it / nblk, nb = it % nblk, k0 = 64 * kb, n0 = 32 * nb;
#pragma unroll 8
        for (int i = 0; i < 32; ++i) { const int kk = 2 * i + (lane >> 5); float w = W[(size_t)(k0 + kk) * N + n0 + (lane & 31)]; if (kscale) w *= kscale[k0 + kk]; scr[kk * 33 + (lane & 31)] = w; }
        asm volatile("s_waitcnt lgkmcnt(0)" ::: "memory");
        const int c = lane & 7;
#pragma unroll
        for (int j = 0; j < 4; ++j) { const int n = (lane >> 3) + 8 * j; const LAS float* s = scr + (8 * c) * 33 + n;
            u32x4 o;
            if (f16) {
                unsigned t0 = cvt_pk_bf16(s[0 * 33], s[1 * 33]), t1 = cvt_pk_bf16(s[2 * 33], s[3 * 33]), t2 = cvt_pk_bf16(s[4 * 33], s[5 * 33]), t3 = cvt_pk_bf16(s[6 * 33], s[7 * 33]);
                o.x = pk_f16(bf_lo(t0), bf_hi(t0)); o.y = pk_f16(bf_lo(t1), bf_hi(t1)); o.z = pk_f16(bf_lo(t2), bf_hi(t2)); o.w = pk_f16(bf_lo(t3), bf_hi(t3)); }
            else { o.x = cvt_pk_bf16(s[0 * 33], s[1 * 33]); o.y = cvt_pk_bf16(s[2 * 33], s[3 * 33]); o.z = cvt_pk_bf16(s[4 * 33], s[5 * 33]); o.w = cvt_pk_bf16(s[6 * 33], s[7 * 33]); }
            *(u32x4*)(WT + (size_t)rowmap(mode, n0 + n) * K + k0 + 8 * c) = o; }
        asm volatile("s_waitcnt lgkmcnt(0)" ::: "memory");
    }
}

struct Args { const float* in[20]; float* out; unsigned char* ws; int ph_lo, ph_hi; };

__device__ __forceinline__ void convert_layer(const Args& a, int L, LAS float* scr, int gw, int NGW, int lane) {
    asm volatile("" : "+v"(lane));
    unsigned char* wb = a.ws + WS_W;
    int rot = 0;
    for (int ff = 0; ff < 2; ++ff) {
        const size_t wo = (size_t)(L * 2 + ff) * DM * DFF;
        bf16* w13t = (bf16*)(wb + ff * W_FFN); bf16* w2t = (bf16*)(wb + ff * W_FFN + W_W2T);
        cvt_job(a.in[4] + wo, DM, DFF, w13t, 1, scr, gw, NGW, lane, rot, true); rot += 1408;
        cvt_job(a.in[5] + wo, DM, DFF, w13t, 2, scr, gw, NGW, lane, rot, true); rot += 1408;
        cvt_job(a.in[6] + wo, DFF, DM, w2t, 0, scr, gw, NGW, lane, rot); rot += 1408;
    }
    const int k = L >> 1;
    unsigned char* wm = wb + W_MIX;
    if ((L & 1) == 0) {
        bf16* w_in_t = (bf16*)(wm + W_MLA_IN);
        cvt_job(a.in[7] + (size_t)k * DM * 704, DM, 704, w_in_t, 4, scr, gw, NGW, lane, rot, true); rot += 352;
        for (int i = gw * 64 + lane; i < 64 * DM / 8; i += NGW * 64) *(u32x4*)(w_in_t + (size_t)704 * DM + (size_t)i * 8) = (u32x4){0u, 0u, 0u, 0u};
        cvt_job(a.in[10] + (size_t)k * QLR * 1536, QLR, 1536, (bf16*)(wm + W_MLA_UQ), 3, scr, gw, NGW, lane, rot, false, a.in[8] + k * QLR); rot += 288;
        cvt_job(a.in[11] + (size_t)k * KVLR * 2048, KVLR, 2048, (bf16*)(wm + W_MLA_UKV), 0, scr, gw, NGW, lane, rot, false, a.in[9] + k * KVLR); rot += 256;
        cvt_job(a.in[12] + (size_t)k * DM * DM, DM, DM, (bf16*)(wm + W_MLA_O), 0, scr, gw, NGW, lane, rot);
    } else {
        cvt_job(a.in[13] + (size_t)k * DM * 2048, DM, 2048, (bf16*)(wm + W_LRU_IN), 0, scr, gw, NGW, lane, rot, true); rot += 1024;
        for (int gn = 0; gn < 16; ++gn) { const int gate = gn >> 2, n = gn & 3;
            cvt_job(a.in[16] + (size_t)((k * 4 + gate) * 4 + n) * 65536, 256, 256, (bf16*)(wm + W_LRU_GATE) + (size_t)(((gate >> 1) * 4 + n) * 2) * 65536, (gate & 1) ? 2 : 1, scr, gw, NGW, lane, rot); rot += 32; }
        cvt_job(a.in[19] + (size_t)k * DM * DM, DM, DM, (bf16*)(wm + W_LRU_OUT), 0, scr, gw, NGW, lane, rot);
    }
}

__device__ __forceinline__ void cast_rows(const float* X, bf16* XN, int gw, int NGW, int lane) {
    asm volatile("" : "+v"(lane));
    for (int m = gw; m < M; m += NGW) {
        const f32x4* xr = (const f32x4*)(X + (size_t)m * DM) + lane; u32x2* o = (u32x2*)(XN + (size_t)m * DM) + lane;
#pragma unroll
        for (int j = 0; j < 4; ++j) { const f32x4 v = xr[64 * j]; o[64 * j] = (u32x2){pk_f16(v[0], v[1]), pk_f16(v[2], v[3])}; }
    }
}
__device__ __forceinline__ void ln_pass(const float* X, float* XO, bf16* XN, const float* g, const float* bt, int gw, int NGW, int lane) {
    asm volatile("" : "+v"(lane));
    f32x4 gv[4], bv[4];
#pragma unroll
    for (int j = 0; j < 4; ++j) { gv[j] = ((const f32x4*)g)[lane + 64 * j]; bv[j] = ((const f32x4*)bt)[lane + 64 * j]; }
    for (int m = gw; m < M; m += NGW) {
        const f32x4* xr = (const f32x4*)(X + (size_t)m * DM) + lane; f32x4* xo = (f32x4*)(XO + (size_t)m * DM) + lane; u32x2* o = (u32x2*)(XN + (size_t)m * DM) + lane;
        f32x4 v[4]; float s = 0.f;
#pragma unroll
        for (int j = 0; j < 4; ++j) { v[j] = xr[64 * j]; s += (v[j][0] + v[j][1]) + (v[j][2] + v[j][3]); }
        const float mean = wave_sum(s) * (1.f / DM); float s2 = 0.f;
#pragma unroll
        for (int j = 0; j < 4; ++j) { v[j] = v[j] - mean; s2 += (v[j][0] * v[j][0] + v[j][1] * v[j][1]) + (v[j][2] * v[j][2] + v[j][3] * v[j][3]); }
        const float rstd = 1.0f / sqrtf(wave_sum(s2) * (1.f / DM) + LN_EPS);
#pragma unroll
        for (int j = 0; j < 4; ++j) { const f32x4 y = v[j] * rstd * gv[j] + bv[j]; xo[64 * j] = y; o[64 * j] = (u32x2){cvt_pk_bf16(y[0], y[1]), cvt_pk_bf16(y[2], y[3])}; }
    }
}
__device__ __forceinline__ void mla_norm_pass(const float* hm, bf16* cqn, bf16* ckvn, bf16* Kr, const float* qg, const float* kvg, const int* pos, int gw, int NGW, int lane) {
    asm volatile("" : "+v"(lane));
    for (int m = gw; m < M; m += NGW) {
        const float* r = hm + (size_t)m * 768;
        const f32x2 a0 = *(const f32x2*)(r + 6 * lane), a1 = *(const f32x2*)(r + 6 * lane + 2), a2 = *(const f32x2*)(r + 6 * lane + 4);
        const f32x4 kv = *(const f32x4*)(r + 384 + 4 * lane);
        const float kr = r[640 + lane];
        const float sq = wave_sum((a0[0] * a0[0] + a0[1] * a0[1]) + (a1[0] * a1[0] + a1[1] * a1[1]) + (a2[0] * a2[0] + a2[1] * a2[1]));
        const float skv = wave_sum((kv[0] * kv[0] + kv[1] * kv[1]) + (kv[2] * kv[2] + kv[3] * kv[3]));
        const float rq = 1.0f / sqrtf(sq * (1.f / QLR) + RMS_EPS), rkv = 1.0f / sqrtf(skv * (1.f / KVLR) + RMS_EPS);
        const f32x2 g0 = *(const f32x2*)(qg + 6 * lane), g1 = *(const f32x2*)(qg + 6 * lane + 2), g2 = *(const f32x2*)(qg + 6 * lane + 4);
        unsigned* oq = (unsigned*)(cqn + (size_t)m * QLR + 6 * lane);
        oq[0] = cvt_pk_bf16(a0[0] * rq * g0[0], a0[1] * rq * g0[1]); oq[1] = cvt_pk_bf16(a1[0] * rq * g1[0], a1[1] * rq * g1[1]); oq[2] = cvt_pk_bf16(a2[0] * rq * g2[0], a2[1] * rq * g2[1]);
        const f32x4 gk = *(const f32x4*)(kvg + 4 * lane);
        *(u32x2*)(ckvn + (size_t)m * KVLR + 4 * lane) = (u32x2){cvt_pk_bf16(kv[0] * rkv * gk[0], kv[1] * rkv * gk[1]), cvt_pk_bf16(kv[2] * rkv * gk[2], kv[3] * rkv * gk[3])};
        const float other = __shfl_xor(kr, 32);
        float c, s; rope_cs(pos[m], lane & 31, c, s);
        const float outv = (lane < 32) ? (kr * c - other * s) : (kr * c + other * s);
        Kr[(size_t)m * 64 + lane] = (bf16)(cvt_pk_bf16(outv, 0.f) & 0xffffu);
    }
}
__device__ __forceinline__ void conv_pass(const bf16* __restrict__ xr, bf16* __restrict__ xc, const float* __restrict__ cw, const float* __restrict__ cb, int gw, int NGW, int lane) {
    asm volatile("" : "+v"(lane));
    constexpr int RPW = 16;
    for (int blk = gw; blk < M / RPW; blk += NGW) {
        const int m0 = blk * RPW, t0 = m0 & (SEQ - 1);
#pragma unroll
        for (int half = 0; half < 2; ++half) {
            const int c0 = half * 512 + lane * 8;
            u32x4 rows[RPW + 3];
#pragma unroll
            for (int i = 0; i < RPW + 3; ++i) { const int tt = t0 + i - 2;
                rows[i] = (tt >= 0 && tt < SEQ) ? *(const u32x4*)(xr + (size_t)(m0 + i - 2) * DM + c0) : (u32x4){0u, 0u, 0u, 0u}; }
            f32x4 k0[4], k1[4];
#pragma unroll
            for (int j = 0; j < 4; ++j) { k0[j] = *(const f32x4*)(cw + j * DM + c0); k1[j] = *(const f32x4*)(cw + j * DM + c0 + 4); }
            const f32x4 b0 = *(const f32x4*)(cb + c0), b1 = *(const f32x4*)(cb + c0 + 4);
#pragma unroll
            for (int i = 0; i < RPW; ++i) {
                f32x4 a0 = b0, a1 = b1;
#pragma unroll
                for (int j = 0; j < 4; ++j) { const u32x4 w = rows[i + j];
                    a0[0] += k0[j][0] * bf_lo(w.x); a0[1] += k0[j][1] * bf_hi(w.x); a0[2] += k0[j][2] * bf_lo(w.y); a0[3] += k0[j][3] * bf_hi(w.y);
                    a1[0] += k1[j][0] * bf_lo(w.z); a1[1] += k1[j][1] * bf_hi(w.z); a1[2] += k1[j][2] * bf_lo(w.w); a1[3] += k1[j][3] * bf_hi(w.w); }
                *(u32x4*)(xc + (size_t)(m0 + i) * DM + c0) = (u32x4){cvt_pk_bf16(a0[0], a0[1]), cvt_pk_bf16(a0[2], a0[3]), cvt_pk_bf16(a1[0], a1[1]), cvt_pk_bf16(a1[2], a1[3])};
            }
        }
    }
}
constexpr int NCHUNK = 32, CLEN = SEQ / NCHUNK;
__device__ __forceinline__ void scan_pass1(const unsigned* P, f32x2* agg, int tid_in, int bx, int gthreads) {
    asm volatile("" : "+v"(tid_in)); const int gtid = bx * 512 + tid_in;
    f32x4* agg4 = (f32x4*)agg;
    for (int T = gtid; T < BATCH * NCHUNK * (DM / 2); T += gthreads) {
        const int chp = T & 511, chunk = (T >> 9) & (NCHUNK - 1), b = T >> 14;
        const size_t base = ((size_t)b * SEQ + (size_t)chunk * CLEN) * DM + 2 * chp;
        {   const u32x2* p = (const u32x2*)(P + base); float h0 = 0.f, s0 = 0.f, h1 = 0.f, s1 = 0.f;
            for (int t0 = 0; t0 < CLEN; t0 += 16) { u32x2 w[16];
#pragma unroll
                for (int i = 0; i < 16; ++i) w[i] = p[(size_t)(t0 + i) * (DM / 2)];
#pragma unroll
                for (int i = 0; i < 16; ++i) { const float la = bf_lo(w[i].x), lb = bf_lo(w[i].y); h0 = __builtin_amdgcn_exp2f(la) * h0 + bf_hi(w[i].x); s0 += la; h1 = __builtin_amdgcn_exp2f(lb) * h1 + bf_hi(w[i].y); s1 += lb; } }
            agg4[((size_t)(0 * BATCH + b) * NCHUNK + chunk) * (DM / 2) + chp] = (f32x4){s0, h0, s1, h1}; }
        {   const u32x2* p = (const u32x2*)(P + (size_t)M * DM + base); float h0 = 0.f, s0 = 0.f, h1 = 0.f, s1 = 0.f;
            for (int t0 = CLEN - 16; t0 >= 0; t0 -= 16) { u32x2 w[16];
#pragma unroll
                for (int i = 0; i < 16; ++i) w[i] = p[(size_t)(t0 + i) * (DM / 2)];
#pragma unroll
                for (int i = 15; i >= 0; --i) { const float la = bf_lo(w[i].x), lb = bf_lo(w[i].y); h0 = __builtin_amdgcn_exp2f(la) * h0 + bf_hi(w[i].x); s0 += la; h1 = __builtin_amdgcn_exp2f(lb) * h1 + bf_hi(w[i].y); s1 += lb; } }
            agg4[((size_t)(1 * BATCH + b) * NCHUNK + chunk) * (DM / 2) + chp] = (f32x4){s0, h0, s1, h1}; }
    }
}
__device__ __forceinline__ void scan_pass2(const unsigned* P, const f32x2* agg, bf16* HF, bf16* GG, int tid_in, int bx, int gthreads) {
    asm volatile("" : "+v"(tid_in)); const int gtid = bx * 512 + tid_in;
    const f32x4* agg4 = (const f32x4*)agg;
    for (int T = gtid; T < BATCH * NCHUNK * (DM / 2); T += gthreads) {
        const int chp = T & 511, chunk = (T >> 9) & (NCHUNK - 1), b = T >> 14;
        const size_t base = ((size_t)b * SEQ + (size_t)chunk * CLEN) * DM + 2 * chp;
        {   float h0 = 0.f, h1 = 0.f;
            const f32x4* ag = agg4 + ((size_t)(0 * BATCH + b) * NCHUNK) * (DM / 2) + chp;
            for (int c0 = 0; c0 < chunk; c0 += 8) { f32x4 ab[8];
#pragma unroll
                for (int i = 0; i < 8; ++i) ab[i] = ag[(size_t)(c0 + i) * (DM / 2)];
#pragma unroll
                for (int i = 0; i < 8; ++i) if (c0 + i < chunk) { h0 = __builtin_amdgcn_exp2f(ab[i][0]) * h0 + ab[i][1]; h1 = __builtin_amdgcn_exp2f(ab[i][2]) * h1 + ab[i][3]; } }
            const u32x2* p = (const u32x2*)(P + base); unsigned* hf = (unsigned*)(HF + base);
            u32x2 w[16], wn[16];
#pragma unroll
            for (int i = 0; i < 16; ++i) w[i] = p[(size_t)i * (DM / 2)];
            for (int t0 = 0; t0 < CLEN; t0 += 16) {
                if (t0 + 16 < CLEN) {
#pragma unroll
                    for (int i = 0; i < 16; ++i) wn[i] = p[(size_t)(t0 + 16 + i) * (DM / 2)]; }
#pragma unroll
                for (int i = 0; i < 16; ++i) { h0 = __builtin_amdgcn_exp2f(bf_lo(w[i].x)) * h0 + bf_hi(w[i].x); h1 = __builtin_amdgcn_exp2f(bf_lo(w[i].y)) * h1 + bf_hi(w[i].y);
                    hf[(size_t)(t0 + i) * (DM / 2)] = cvt_pk_bf16(h0, h1); }
#pragma unroll
                for (int i = 0; i < 16; ++i) w[i] = wn[i];
            } }
        __threadfence_block();
        {   float h0 = 0.f, h1 = 0.f;
            const f32x4* ag = agg4 + ((size_t)(1 * BATCH + b) * NCHUNK) * (DM / 2) + chp;
            for (int c0 = NCHUNK - 1; c0 > chunk; c0 -= 8) { f32x4 ab[8];
#pragma unroll
                for (int i = 0; i < 8; ++i) ab[i] = ag[(size_t)(c0 - i) * (DM / 2)];
#pragma unroll
                for (int i = 0; i < 8; ++i) if (c0 - i > chunk) { h0 = __builtin_amdgcn_exp2f(ab[i][0]) * h0 + ab[i][1]; h1 = __builtin_amdgcn_exp2f(ab[i][2]) * h1 + ab[i][3]; } }
            const u32x2* p = (const u32x2*)(P + (size_t)M * DM + base); const unsigned* hf = (const unsigned*)(HF + base); unsigned* gg = (unsigned*)(GG + base);
            for (int t0 = CLEN - 16; t0 >= 0; t0 -= 16) { u32x2 w[16]; unsigned f[16], g[16];
#pragma unroll
                for (int i = 0; i < 16; ++i) { w[i] = p[(size_t)(t0 + i) * (DM / 2)]; f[i] = hf[(size_t)(t0 + i) * (DM / 2)]; g[i] = gg[(size_t)(t0 + i) * (DM / 2)]; }
#pragma unroll
                for (int i = 15; i >= 0; --i) { h0 = __builtin_amdgcn_exp2f(bf_lo(w[i].x)) * h0 + bf_hi(w[i].x); h1 = __builtin_amdgcn_exp2f(bf_lo(w[i].y)) * h1 + bf_hi(w[i].y);
                    gg[(size_t)(t0 + i) * (DM / 2)] = cvt_pk_bf16(bf_lo(g[i]) * (bf_lo(f[i]) + h0), bf_hi(g[i]) * (bf_hi(f[i]) + h1)); } } }
    }
}

#define XB_TMO      128
#define XB_XCNT(j)  (256  + 64 * (j))
#define XB_XSUB(j)  (1280 + 64 * (j))
#define XB_XGEN(j)  (2304 + 64 * (j))
#define XB_TOP      3328
#define XB_TOPGEN   3392
#define XCD_BAR_WORDS 3456
#define XB_SPIN_CAP (1u << 18)
__device__ __forceinline__ unsigned xb_ld(unsigned* p)              { return __hip_atomic_load(p, __ATOMIC_RELAXED, __HIP_MEMORY_SCOPE_AGENT); }
__device__ __forceinline__ unsigned xb_add(unsigned* p, unsigned v) { return __hip_atomic_fetch_add(p, v, __ATOMIC_RELAXED, __HIP_MEMORY_SCOPE_AGENT); }
__device__ __forceinline__ unsigned xb_xcc_id() { return (unsigned)__builtin_amdgcn_s_getreg((3 << 11) | 20) & 0xFu; }
#define XB_SPIN(cond, bar) do { unsigned _sp = 0; while (cond) { __builtin_amdgcn_s_sleep(1); \
    if ((++_sp & 255u) == 0u) { if (xb_ld(&(bar)[XB_TMO])) break; if (_sp > XB_SPIN_CAP) { atomicAdd(&(bar)[XB_TMO], 1u); break; } } } } while (0)
struct XcdBarrier { unsigned* bar; unsigned x; volatile LAS unsigned* st; };
__device__ __forceinline__ XcdBarrier xcd_barrier_post(unsigned* bar, volatile LAS unsigned* st) {
    XcdBarrier b; b.bar = bar; b.x = xb_xcc_id(); b.st = st;
    if (threadIdx.x == 0) (void)xb_add(&bar[XB_XCNT(b.x)], 1u);
    return b;
}
__device__ __forceinline__ void xcd_barrier_complete(unsigned* bar, unsigned x, unsigned& nloc, unsigned& nx) {
    const unsigned G = gridDim.x * gridDim.y * gridDim.z;
    unsigned sum, cnt, mine, sp = 0u;
    for (;;) {
        sum = 0u; cnt = 0u; mine = 0u;
#pragma unroll
        for (unsigned j = 0; j < 16; ++j) { const unsigned c = xb_ld(&bar[XB_XCNT(j)]); sum += c; cnt += (c > 0u) ? 1u : 0u; mine = (j == x) ? c : mine; }
        if (sum == G) break;
        __builtin_amdgcn_s_sleep(1);
        if ((++sp & 255u) == 0u) { if (xb_ld(&bar[XB_TMO])) break; if (sp > XB_SPIN_CAP) { atomicAdd(&bar[XB_TMO], 1u); break; } }
    }
    nloc = mine > 0u ? mine : 1u; nx = cnt > 0u ? cnt : 1u;
}
__device__ __forceinline__ void xcd_barrier(const XcdBarrier& b) {
    asm volatile("s_waitcnt vmcnt(0)" ::: "memory");
    __syncthreads();
    if (threadIdx.x == 0) {
        unsigned* bar = b.bar;
        __builtin_amdgcn_s_waitcnt(0);
        unsigned nloc = b.st[0], nx = b.st[1];
        if (nloc == 0u) { xcd_barrier_complete(bar, b.x, nloc, nx); b.st[0] = nloc; b.st[1] = nx; }
        const unsigned old = xb_add(&bar[XB_XSUB(b.x)], 1u);
        const unsigned gen = old / nloc;
        if (old + 1u == (gen + 1u) * nloc) {
            __builtin_amdgcn_fence(__ATOMIC_RELEASE, "agent");
            asm volatile("s_waitcnt vmcnt(0)" ::: "memory");
            const unsigned og = xb_add(&bar[XB_TOP], 1u);
            const unsigned tg = og / nx;
            if (og + 1u == (tg + 1u) * nx) xb_add(&bar[XB_TOPGEN], 1u);
            else XB_SPIN(xb_ld(&bar[XB_TOPGEN]) == tg, bar);
            __builtin_amdgcn_fence(__ATOMIC_ACQUIRE, "agent");
            xb_add(&bar[XB_XGEN(b.x)], 1u);
            asm volatile("s_waitcnt vmcnt(0)" ::: "memory");
        } else {
            XB_SPIN(xb_ld(&bar[XB_XGEN(b.x)]) == gen, bar);
            __builtin_amdgcn_fence(__ATOMIC_ACQUIRE, "agent");
            asm volatile("s_waitcnt vmcnt(0)" ::: "memory");
        }
    }
    __syncthreads();
}

constexpr int LDS_BYTES = 147456;
static_assert(attn::SHM_ATTN <= pg8::STAGE_BYTES, "attention LDS fits the stage region");

__global__ void __launch_bounds__(512, 2) fwd_megakernel(Args a) {
    extern __shared__ __attribute__((aligned(16))) unsigned char lds[];
    cg::grid_group grid = cg::this_grid();
    const int tid = threadIdx.x, lane = tid & 63, wave = __builtin_amdgcn_readfirstlane(tid >> 6);
    const int G = gridDim.x, bx = blockIdx.x;
    const int gw = bx * 8 + wave, NGW = G * 8;
    const int vcu = (G % 8 == 0) ? (bx % 8) * (G / 8) + bx / 8 : bx;
    LAS unsigned char* ldsl = (LAS unsigned char*)lds;
    LAS float* scr = (LAS float*)(ldsl + wave * 16384);
    unsigned char* ws = a.ws;
    const float* x_in = a.in[0]; const int* pos = (const int*)a.in[1];
    float* xbuf = a.out;
    bf16* xn = (bf16*)(ws + WS_R0);
    unsigned char* T = ws + WS_T;
    unsigned char* wb = ws + WS_W;
    int ph = 0;
    volatile LAS unsigned* bst = (volatile LAS unsigned*)(ldsl + 131072 + 12288);
    if (tid < 2) bst[tid] = 0u;
    __syncthreads();
    XcdBarrier bar = xcd_barrier_post((unsigned*)ws + 1024, bst);
    int nsync = 0;
    unsigned long long* xslots = (unsigned long long*)(ws + 42 * MiB);
#ifndef ONLY
#define ONLY -1
#endif
#define EN(k) (ONLY < 0 || ONLY == (k))
#define RUN(p) (a.ph_lo <= (p) && (p) < a.ph_hi)
#define SEAM() do { if (RUN(ph) && RUN(ph + 1)) { if (nsync == 0) grid.sync(); else { xcd_barrier(bar); } ++nsync; } ++ph; } while (0)

    if (EN(0) && RUN(ph)) { { int tl = tid; asm volatile("" : "+v"(tl)); for (int i = bx * 512 + tl; i < 2 * M * 2; i += G * 512) ((float*)(ws + 43 * MiB))[i] = 0.f; }
        convert_layer(a, 0, scr, gw, NGW, lane); cast_rows(x_in, xn, gw, NGW, lane); }
    SEAM();

#pragma nounroll
    for (int s = 0; s < 3 * DEPTH; ++s) {
        const int L = s / 3, j = s - 3 * L;
        if (j != 1) {
            const int ff = j >> 1;
            bf16* hbuf = (bf16*)(T + T_H);
            if (EN(1) && RUN(ph)) {
                pg8::Gemm g{xn, (const bf16*)(wb + ff * W_FFN), DM, DM, DM, 0, 0, 0}; pg8::StaticOrder S; S.init(M, 2 * DFF, G, bx);
                pg8::EpiSwiglu E{hbuf, DFF};
                pg8::gemm_phase<pg8::EpiSwiglu>(ldsl, g, S, E);
            }
            SEAM();
            if (EN(2) && RUN(ph)) {
                pg8::Gemm g{hbuf, (const bf16*)(wb + ff * W_FFN + W_W2T), DFF, DFF, DFF, 0, 0, 0}; pg8::StaticOrder S; S.init(M, DM, G, bx);
                pg8::EpiResid E{xn, xbuf, (s == 3 * DEPTH - 1) ? 1 : 0, ALPHA, 0.5f, a.in[2] + (size_t)s * DM, a.in[3] + (size_t)s * DM, xslots, 16u + (unsigned)s, (unsigned*)ws + 16};
                pg8::gemm_phase<pg8::EpiResid>(ldsl, g, S, E);
            }
            SEAM();
        } else if ((L & 1) == 0) {
            const int k = L >> 1;
            unsigned char* wm = wb + W_MIX;
            float* mstat = (float*)(ws + 43 * MiB) + (size_t)k * M * 2;
            bf16* Qn = (bf16*)(T + T_QN); bf16* Qr = (bf16*)(T + T_QR); bf16* cqn = (bf16*)(T + T_CQN); bf16* ckvn = (bf16*)(T + T_CKVN);
            bf16* Kn = (bf16*)(T + T_KN); bf16* Kr = (bf16*)(T + T_KR); bf16* Vb = (bf16*)(T + T_V);
            if (EN(3) && RUN(ph)) {
                pg8::Gemm g{xn, (const bf16*)(wm + W_MLA_IN), DM, DM, DM, 0, 0, 0}; pg8::StaticOrder S; S.init(M, 768, G, bx);
                pg8::EpiMlaIn E{cqn, ckvn, Kr, mstat, pos};
                pg8::gemm_phase<pg8::EpiMlaIn>(ldsl, g, S, E);
            }
            SEAM();
            if (RUN(ph)) {
                if (EN(5)) { pg8::Gemm g{cqn, (const bf16*)(wm + W_MLA_UQ), QLR, QLR, QLR, 0, 0, 0}; pg8::StaticOrder S; S.init(M, 1536, G, bx);
                  pg8::EpiQ E{Qn, Qr, pos, mstat};
                  pg8::gemm_phase<pg8::EpiQ>(ldsl, g, S, E); }
                if (EN(6)) { pg8::Gemm g{ckvn, (const bf16*)(wm + W_MLA_UKV), KVLR, KVLR, KVLR, 0, 0, 0}; pg8::StaticOrder S; S.init(M, 2048, G, bx);
                  pg8::EpiKV E{Kn, Vb, mstat};
                  pg8::gemm_phase<pg8::EpiKV>(ldsl, g, S, E); }
            }
            SEAM();
            if (EN(7) && RUN(ph)) {
                for (int U = vcu; U < BATCH * HEADS * (SEQ / 256); U += G) {
                    const int bh = U >> 4, qb = U & 15, b = bh >> 3, h = bh & 7;
                    attn::attn_unit((long)b * SEQ, h, qb * 256, Qn, Qr, Kn, Kr, Vb, Qn, (char*)lds);
                }
            }
            SEAM();
            if (EN(8) && RUN(ph)) {
                pg8::Gemm g{Qn, (const bf16*)(wm + W_MLA_O), DM, DM, DM, 0, 0, 0}; pg8::StaticOrder S; S.init(M, DM, G, bx);
                pg8::EpiResid E{xn, xbuf, 0, ALPHA, 1.0f, a.in[2] + (size_t)s * DM, a.in[3] + (size_t)s * DM, xslots, 16u + (unsigned)s, (unsigned*)ws + 16};
                pg8::gemm_phase<pg8::EpiResid>(ldsl, g, S, E);
            }
            SEAM();
        } else {
            const int k = L >> 1;
            unsigned char* wm = wb + W_MIX;
            bf16* gg = (bf16*)(T + T_GG); bf16* xr = (bf16*)(T + T_XR); unsigned* P = (unsigned*)(T + T_P); f32x2* agg = (f32x2*)(T + T_AGG);
            bf16* xc = (bf16*)xbuf;
            if (EN(9) && RUN(ph)) {
                pg8::Gemm g{xn, (const bf16*)(wm + W_LRU_IN), DM, DM, DM, 0, 0, 0}; pg8::StaticOrder S; S.init(M, 2048, G, bx);
                pg8::EpiLruIn E{gg, xr};
                pg8::gemm_phase<pg8::EpiLruIn>(ldsl, g, S, E);
            }
            SEAM();
            float* lstab = (float*)(T + T_AGG + 4 * MiB);
            if (EN(10) && RUN(ph) && bx == 0) { const float* lm = a.in[18] + (size_t)k * 2 * DM; int tl = tid; asm volatile("" : "+v"(tl)); for (int i = tl; i < 2 * DM; i += 512) lstab[i] = -8.0f * LOG2E * logf(1.0f + expf(-lm[i])); }
            if (EN(10) && RUN(ph)) conv_pass(xr, xc, a.in[14] + (size_t)k * 4 * DM, a.in[15] + (size_t)k * DM, gw, NGW, lane);
            SEAM();
            if (EN(11) && RUN(ph)) {
                pg8::Gemm g{xc, (const bf16*)(wm + W_LRU_GATE), DM, 256, 256, 1, 3, 256}; pg8::StaticOrder S; S.init(M, 4096, G, bx);
                pg8::EpiGate E{P, xc, a.in[17] + (size_t)k * 4 * DM, lstab};
                pg8::gemm_phase<pg8::EpiGate>(ldsl, g, S, E);
            }
            SEAM();
            if (EN(12) && RUN(ph)) scan_pass1(P, agg, tid, bx, G * 512);
            SEAM();
            if (EN(13) && RUN(ph)) scan_pass2(P, agg, xc, gg, tid, bx, G * 512);
            SEAM();
            if (EN(14) && RUN(ph)) {
                pg8::Gemm g{gg, (const bf16*)(wm + W_LRU_OUT), DM, DM, DM, 0, 0, 0}; pg8::StaticOrder S; S.init(M, DM, G, bx);
                pg8::EpiResid E{xn, xbuf, 0, ALPHA, 1.0f, a.in[2] + (size_t)s * DM, a.in[3] + (size_t)s * DM, xslots, 16u + (unsigned)s, (unsigned*)ws + 16};
                pg8::gemm_phase<pg8::EpiResid>(ldsl, g, S, E);
            }
            SEAM();
        }
        if (j == 2 && L + 1 < DEPTH) {
            if (EN(15) && RUN(ph)) convert_layer(a, L + 1, scr, gw, NGW, lane);
            SEAM();
        }
    }
#undef RUN
#undef SEAM
}

extern "C" void kernel_launch(void* const* d_in, const int* in_sizes, int n_in, void* d_out, int out_size, void* d_ws, size_t ws_size, hipStream_t stream) {
    static int grid = 0;
    if (grid == 0) {
        if (n_in != 20 || in_sizes[0] != M * DM || out_size != M * DM || ws_size < WS_END) {
            fprintf(stderr, "kernel_launch: unexpected shapes (n_in %d, in0 %d, out %d, ws %zu need %zu)\n", n_in, n_in > 0 ? in_sizes[0] : -1, out_size, ws_size, (size_t)WS_END); grid = -1; return; }
        int dev = 0, cus = 0, per_cu = 0;
        hipGetDevice(&dev); hipDeviceGetAttribute(&cus, hipDeviceAttributeMultiprocessorCount, dev);
        if (hipFuncSetAttribute((const void*)fwd_megakernel, hipFuncAttributeMaxDynamicSharedMemorySize, LDS_BYTES) != hipSuccess) { fprintf(stderr, "kernel_launch: hipFuncSetAttribute failed\n"); grid = -1; return; }
        if (hipOccupancyMaxActiveBlocksPerMultiprocessor(&per_cu, (const void*)fwd_megakernel, 512, LDS_BYTES) != hipSuccess || per_cu < 1) { fprintf(stderr, "kernel_launch: occupancy query gives %d\n", per_cu); per_cu = 1; }
        (void)hipGetLastError();
        grid = cus;
    }
    if (grid < 0) return;
    if (hipMemsetAsync(d_ws, 0, 65536, stream) != hipSuccess) { fprintf(stderr, "kernel_launch: memset failed\n"); return; }
    Args a{};
    for (int i = 0; i < 20; ++i) a.in[i] = (const float*)d_in[i];
    a.out = (float*)d_out; a.ws = (unsigned char*)d_ws;
#if MK_PER_PHASE
    for (int p = 0; p < N_PHASES; ++p) { a.ph_lo = p; a.ph_hi = p + 1; hipLaunchKernelGGL(fwd_megakernel, dim3(grid), dim3(512), LDS_BYTES, stream, a); }
#else
    a.ph_lo = 0; a.ph_hi = 1 << 20;
    void* args[] = {&a};
    hipError_t e = hipLaunchCooperativeKernel((const void*)fwd_megakernel, dim3(grid), dim3(512), args, LDS_BYTES, stream);
    if (e != hipSuccess) fprintf(stderr, "kernel_launch: cooperative launch failed: %s (grid %d)\n", hipGetErrorString(e), grid);
#endif
}
```

```cpp
#include <hip/hip_runtime.h>
#include <hip/hip_cooperative_groups.h>
#include <cstdio>
#include <cstdint>
namespace cg = cooperative_groups;

#ifndef MK_PER_PHASE
#define MK_PER_PHASE 0
#endif

#define LAS __attribute__((address_space(3)))
typedef unsigned short bf16;
typedef short bf16x8 __attribute__((ext_vector_type(8)));
typedef short s16x4 __attribute__((ext_vector_type(4)));
typedef float f32x4 __attribute__((ext_vector_type(4)));
typedef float f32x2 __attribute__((ext_vector_type(2)));
typedef float f32x16 __attribute__((ext_vector_type(16)));
typedef unsigned u32x4 __attribute__((ext_vector_type(4)));
typedef unsigned u32x2 __attribute__((ext_vector_type(2)));

constexpr int BATCH = 8, SEQ = 4096, DM = 1024, M = BATCH * SEQ, DFF = 2816, DEPTH = 4;
constexpr int HEADS = 8, QLR = 384, KVLR = 256;
constexpr float ALPHA = 1.681792830507429f;
constexpr float LN_EPS = 1e-5f, RMS_EPS = 1e-6f;
constexpr float QSCALE = 0.10411754627697264f;
constexpr float THR2 = 11.541560327111707f;
constexpr float LOG2E = 1.4426950408889634f;

constexpr size_t MiB = 1u << 20;
constexpr size_t WS_W = 1 * MiB;
constexpr size_t W_FFN = 16 * MiB + MiB / 2;
constexpr size_t W_W2T = 11 * MiB;
constexpr size_t W_MIX = 33 * MiB;
constexpr size_t W_MLA_IN = 0, W_MLA_UQ = MiB + MiB / 2, W_MLA_UKV = W_MLA_UQ + MiB + MiB / 8, W_MLA_O = W_MLA_UKV + MiB;
constexpr size_t W_LRU_IN = 0, W_LRU_GATE = 4 * MiB, W_LRU_OUT = 6 * MiB;
constexpr size_t WS_R0 = 44 * MiB;
constexpr size_t WS_T = 108 * MiB;
constexpr size_t T_H = 0;
constexpr size_t T_HMLA = 0, T_QN = 0, T_QR = 64 * MiB, T_CQN = 96 * MiB, T_CKVN = 120 * MiB, T_KN = 136 * MiB, T_KR = 200 * MiB, T_V = 204 * MiB;
constexpr size_t T_GG = 0, T_P = 64 * MiB, T_XR = 64 * MiB, T_AGG = 320 * MiB;
constexpr size_t WS_END = WS_T + 332 * MiB;
constexpr int N_PHASES = 40;
#ifndef PROBE
#define PROBE 0
#endif

typedef __bf16 bf16x2_t __attribute__((ext_vector_type(2)));
__device__ __forceinline__ unsigned cvt_pk_bf16(float lo, float hi) { const f32x2 v = {lo, hi}; const bf16x2_t b = __builtin_convertvector(v, bf16x2_t); return __builtin_bit_cast(unsigned, b); }
typedef _Float16 h16x2 __attribute__((ext_vector_type(2)));
typedef _Float16 f16x8 __attribute__((ext_vector_type(8)));
__device__ __forceinline__ unsigned pk_f16(float a, float b) { h16x2 v = {(_Float16)a, (_Float16)b}; return __builtin_bit_cast(unsigned, v); }
__device__ __forceinline__ float f16_lo(unsigned w) { const h16x2 v = __builtin_bit_cast(h16x2, w); return (float)v[0]; }
__device__ __forceinline__ float f16_hi(unsigned w) { const h16x2 v = __builtin_bit_cast(h16x2, w); return (float)v[1]; }
__device__ __forceinline__ float bf_lo(unsigned w) { return __uint_as_float(w << 16); }
__device__ __forceinline__ float bf_hi(unsigned w) { return __uint_as_float(w & 0xffff0000u); }
__device__ __forceinline__ float fast_sigmoid(float x) { return __builtin_amdgcn_rcpf(1.0f + __builtin_amdgcn_exp2f(-x * LOG2E)); }
__device__ __forceinline__ float silu_f(float x) { return x * fast_sigmoid(x); }
__device__ __forceinline__ float gelu_tanh_f(float x) { const float z = 0.7978845608028654f * (x + 0.044715f * x * x * x); return x * fast_sigmoid(2.0f * z); }
__device__ __forceinline__ float wave_sum(float v) {
#pragma unroll
    for (int o = 1; o < 64; o <<= 1) v += __shfl_xor(v, o);
    return v;
}
__device__ const double INV_REV[32] = {0.15915494309189535, 0.11934937021124886, 0.08949940160889101, 0.06711508300522726, 0.050329212104487035, 0.03774158471741977, 0.0283021958306234, 0.02122365276477766,
    0.015915494309189534, 0.011934937021124886, 0.008949940160889102, 0.006711508300522725, 0.005032921210448704, 0.003774158471741977, 0.00283021958306234, 0.0021223652764777662,
    0.0015915494309189536, 0.0011934937021124885, 0.0008949940160889102, 0.0006711508300522726, 0.0005032921210448703, 0.00037741584717419774, 0.00028302195830623395, 0.0002122365276477766,
    0.00015915494309189535, 0.00011934937021124886, 8.949940160889102e-05, 6.711508300522725e-05, 5.0329212104487035e-05, 3.774158471741978e-05, 2.8302195830623396e-05, 2.122365276477766e-05};
__device__ __forceinline__ void rope_cs(int pos, int j, float& c, float& s) {
    double rev = (double)pos * INV_REV[j];
    rev -= (double)(long long)rev;
    const float f = (float)rev;
    c = __builtin_amdgcn_cosf(f); s = __builtin_amdgcn_sinf(f);
}

namespace pg8 {
constexpr int BM = 256, BK = 64, HALF = 128, HTB = HALF * BK * 2, STAGE_BYTES = 8 * HTB, NXCD = 8, WGM = 8;
__host__ __device__ __forceinline__ int lds_byte(int r, int c) { const int st = (r >> 4) * 2 + (c >> 5), rr = r & 15, cc = c & 31, ob = rr * 64 + cc * 2; return st * 1024 + (ob ^ (((ob >> 9) & 1) << 5)); }
__host__ __device__ __forceinline__ void stage_rc(int b, int& R, int& C) { const int st = b / 1024, sb = b % 1024, swz = sb ^ (((sb >> 9) & 1) << 5); R = (st >> 1) * 16 + swz / 64; C = (st & 1) * 32 + (swz % 64) / 2; }
__host__ __device__ __forceinline__ int perm32(int rho) { const int n = rho >> 4, i = rho & 15; return 8 * (i >> 2) + 4 * n + (i & 3); }

struct Unit { int pm, pn; };
struct Gemm { const bf16* A; const bf16* Bt; int lda, ldb, K; int a_sh, a_mask, a_cols; };

struct StaticOrder {
    int nM, nN, nwg, G, c;
    __device__ void init(int M_, int N_, int G_, int c_) { nM = M_ / BM; nN = N_ / BM; nwg = nM * nN; G = G_; c = c_; }
    __device__ bool next(int i, Unit& u) const {
        const long L = (long)i * G + c; if (L >= nwg) return false;
        int wgid = (int)L; { const int q = nwg / NXCD, r = nwg % NXCD, xcd = wgid % NXCD, off = wgid / NXCD; wgid = (xcd < r ? xcd * (q + 1) : r * (q + 1) + (xcd - r) * q) + off; }
        const int nig = WGM * nN, gid = wgid / nig, fm = gid * WGM, gsz = (nM - fm) < WGM ? (nM - fm) : WGM;
        u.pm = fm + ((wgid % nig) % gsz); u.pn = (wgid % nig) / gsz; return true;
    }
};

typedef f32x4 Acc[2][2][4][2];

struct EpiSwiglu {
    static constexpr bool PERM = true, FUSED = false, F16 = true;
    bf16* H; int ldh;
    __device__ __forceinline__ void operator()(const Acc& acc, const Unit& u, int wr, int wc, int fr, int fq) const {
        const int row0 = u.pm * BM + wr * 64 + fr, col = u.pn * 128 + wc * 32 + 8 * fq;
#pragma unroll
        for (int ai = 0; ai < 2; ++ai)
#pragma unroll
            for (int m = 0; m < 4; ++m) {
                bf16* p = H + (size_t)(row0 + ai * HALF + m * 16) * ldh + col;
                const f32x4 g0 = acc[ai][0][m][0], g1 = acc[ai][0][m][1], u0 = acc[ai][1][m][0], u1 = acc[ai][1][m][1];
                u32x4 w;
                w.x = cvt_pk_bf16(silu_f(g0[0]) * u0[0], silu_f(g0[1]) * u0[1]); w.y = cvt_pk_bf16(silu_f(g0[2]) * u0[2], silu_f(g0[3]) * u0[3]);
                w.z = cvt_pk_bf16(silu_f(g1[0]) * u1[0], silu_f(g1[1]) * u1[1]); w.w = cvt_pk_bf16(silu_f(g1[2]) * u1[2], silu_f(g1[3]) * u1[3]);
                *(u32x4*)p = w;
            }
    }
};
struct EpiResid {
    static constexpr bool PERM = true, FUSED = true, F16 = false;
    bf16* XN; float* Y; int wr_f32; float alpha, s; const float* lg; const float* lb;
    unsigned long long* xslots;
    unsigned tag;
    unsigned* tmo;
    __device__ __forceinline__ void fused(Acc& acc, const Unit& u, int wr, int wc, int fr, int fq, LAS unsigned char* lds, int wid, int lane) const {
        LAS f32x2* P = (LAS f32x2*)lds;
        LAS f32x2* S = (LAS f32x2*)(lds + 8192);
        const int col0 = u.pn * BM + wc * 32 + 8 * fq;
#pragma unroll
        for (int ai = 0; ai < 2; ++ai) {
#pragma unroll
            for (int m = 0; m < 4; ++m) { const size_t off = (size_t)(u.pm * BM + ai * HALF + wr * 64 + m * 16 + fr) * DM + col0;
#pragma unroll
                for (int bj = 0; bj < 2; ++bj) { const u32x4 hx = *(const u32x4*)(XN + off + bj * HALF);
                    const f32x4 x0 = {f16_lo(hx.x), f16_hi(hx.x), f16_lo(hx.y), f16_hi(hx.y)}, x1 = {f16_lo(hx.z), f16_hi(hx.z), f16_lo(hx.w), f16_hi(hx.w)};
                    acc[ai][bj][m][0] = x0 * alpha + acc[ai][bj][m][0] * s; acc[ai][bj][m][1] = x1 * alpha + acc[ai][bj][m][1] * s; }
                asm volatile("" : "+v"(acc[ai][0][m][0]), "+v"(acc[ai][0][m][1]), "+v"(acc[ai][1][m][0]), "+v"(acc[ai][1][m][1])); }
            asm volatile("" ::: "memory");
        }
        f32x4 gv[2][2], bv[2][2];
#pragma unroll
        for (int bj = 0; bj < 2; ++bj)
#pragma unroll
            for (int n = 0; n < 2; ++n) { gv[bj][n] = *(const f32x4*)(lg + col0 + bj * HALF + n * 4); bv[bj][n] = *(const f32x4*)(lb + col0 + bj * HALF + n * 4); }
#pragma unroll
        for (int ai = 0; ai < 2; ++ai)
#pragma unroll
            for (int m = 0; m < 4; ++m) {
                float sm = 0.f;
#pragma unroll
                for (int bj = 0; bj < 2; ++bj)
#pragma unroll
                    for (int n = 0; n < 2; ++n) { const f32x4 x = acc[ai][bj][m][n]; sm += (x[0] + x[1]) + (x[2] + x[3]); }
                sm += __shfl_xor(sm, 16); sm += __shfl_xor(sm, 32);
                const float mw = sm * (1.0f / 64.0f); float q = 0.f;
#pragma unroll
                for (int bj = 0; bj < 2; ++bj)
#pragma unroll
                    for (int n = 0; n < 2; ++n) { const f32x4 d = acc[ai][bj][m][n] - mw; q += (d[0] * d[0] + d[1] * d[1]) + (d[2] * d[2] + d[3] * d[3]); }
                q += __shfl_xor(q, 16); q += __shfl_xor(q, 32);
                if (fq == 0) P[(ai * HALF + wr * 64 + m * 16 + fr) * 4 + wc] = (f32x2){mw, q};
            }
        asm volatile("s_waitcnt lgkmcnt(0)" ::: "memory"); __builtin_amdgcn_s_barrier(); asm volatile("" ::: "memory");
        const int row = wid * 32 + (lane & 31);
        bool bad = false;
        if (lane < 32) {
            const f32x2 a = P[row * 4 + 0], b = P[row * 4 + 1], c = P[row * 4 + 2], d = P[row * 4 + 3];
            const float mt = (a.x + b.x + c.x + d.x) * 0.25f;
            const float da = a.x - mt, db = b.x - mt, dc = c.x - mt, dd = d.x - mt;
            const float m2 = (a.y + b.y) + (c.y + d.y) + 64.0f * ((da * da + db * db) + (dc * dc + dd * dd));
            unsigned long long* slot = xslots + (size_t)(u.pm * BM + row) * 4;
            const unsigned long long mine = ((unsigned long long)((__float_as_uint(m2) & ~31u) | tag) << 32) | __float_as_uint(mt);
            __hip_atomic_store(slot + u.pn, mine, __ATOMIC_RELAXED, __HIP_MEMORY_SCOPE_AGENT);
            unsigned long long w[4]; unsigned spins = 0;
            for (;;) {
                bool ok = true;
#pragma unroll
                for (int t = 0; t < 4; ++t) { w[t] = (t == u.pn) ? mine : __hip_atomic_load(slot + t, __ATOMIC_RELAXED, __HIP_MEMORY_SCOPE_AGENT); ok = ok && (((unsigned)(w[t] >> 32) & 31u) == tag); }
                if (ok) break;
                if (++spins > (1u << 20)) { __hip_atomic_store(tmo, 1u, __ATOMIC_RELAXED, __HIP_MEMORY_SCOPE_AGENT); bad = true; break; }
            }
            float mtv[4], m2v[4]; float ms = 0.f;
#pragma unroll
            for (int t = 0; t < 4; ++t) { mtv[t] = __uint_as_float((unsigned)w[t]); m2v[t] = __uint_as_float((unsigned)(w[t] >> 32) & ~31u); ms += mtv[t]; }
            const float mean = ms * 0.25f; float q = 0.f;
#pragma unroll
            for (int t = 0; t < 4; ++t) { const float dm = mtv[t] - mean; q += m2v[t] + 256.0f * dm * dm; }
            S[row] = (f32x2){mean, bad ? __builtin_nanf("") : 1.0f / sqrtf(q * (1.0f / 1024.0f) + LN_EPS)};
        }
        asm volatile("s_waitcnt vmcnt(0) lgkmcnt(0)" ::: "memory"); __builtin_amdgcn_s_barrier(); asm volatile("" ::: "memory");
#pragma unroll
        for (int ai = 0; ai < 2; ++ai)
#pragma unroll
            for (int m = 0; m < 4; ++m) { const int r = ai * HALF + wr * 64 + m * 16 + fr; const f32x2 sr = S[r]; const size_t off = (size_t)(u.pm * BM + r) * DM + col0;
#pragma unroll
                for (int bj = 0; bj < 2; ++bj) {
                    f32x4 o0 = (acc[ai][bj][m][0] - sr.x) * sr.y * gv[bj][0] + bv[bj][0], o1 = (acc[ai][bj][m][1] - sr.x) * sr.y * gv[bj][1] + bv[bj][1];
                    *(u32x4*)(XN + off + bj * HALF) = (u32x4){pk_f16(o0[0], o0[1]), pk_f16(o0[2], o0[3]), pk_f16(o1[0], o1[1]), pk_f16(o1[2], o1[3])};
                    if (wr_f32) { *(f32x4*)(Y + off + bj * HALF) = o0; *(f32x4*)(Y + off + bj * HALF + 4) = o1; } } }
    }
};
__device__ __forceinline__ u32x4 pack8(const f32x4 a, const f32x4 b) { u32x4 w; w.x = cvt_pk_bf16(a[0], a[1]); w.y = cvt_pk_bf16(a[2], a[3]); w.z = cvt_pk_bf16(b[0], b[1]); w.w = cvt_pk_bf16(b[2], b[3]); return w; }
struct EpiMlaIn {
    static constexpr bool PERM = true, FUSED = false, F16 = true;
    bf16* CQ; bf16* CKV; bf16* KR; float* stat; const int* pos;
    __device__ __forceinline__ void operator()(const Acc& acc, const Unit& u, int wr, int wc, int fr, int fq) const {
        const int row0 = u.pm * BM + wr * 64 + fr, lc = wc * 32 + 8 * fq;
#pragma unroll
        for (int ai = 0; ai < 2; ++ai)
#pragma unroll
            for (int m = 0; m < 4; ++m) { const int row = row0 + ai * HALF + m * 16;
#pragma unroll
                for (int bj = 0; bj < 2; ++bj) { const int seg = u.pn * 2 + bj; const f32x4 v0 = acc[ai][bj][m][0], v1 = acc[ai][bj][m][1];
                    if (seg < 5) {
                        float ss = (v0[0] * v0[0] + v0[1] * v0[1]) + (v0[2] * v0[2] + v0[3] * v0[3]) + (v1[0] * v1[0] + v1[1] * v1[1]) + (v1[2] * v1[2] + v1[3] * v1[3]);
                        ss += __shfl_xor(ss, 16); ss += __shfl_xor(ss, 32);
                        if (fq == 0) atomicAdd(stat + (size_t)row * 2 + (seg >= 3 ? 1 : 0), ss);
                        bf16* dst = (seg < 3) ? CQ + (size_t)row * QLR + seg * 128 + lc : CKV + (size_t)row * KVLR + (seg - 3) * 128 + lc;
                        *(u32x4*)dst = pack8(v0, v1);
                    } else if (wc < 2) {
                        const int jj0 = 16 * wc + 4 * fq; const int ps = pos[row]; f32x4 o1, o2;
#pragma unroll
                        for (int e = 0; e < 4; ++e) { float c, sn; rope_cs(ps, jj0 + e, c, sn); o1[e] = v0[e] * c - v1[e] * sn; o2[e] = v1[e] * c + v0[e] * sn; }
                        *(u32x2*)(KR + (size_t)row * 64 + jj0) = (u32x2){cvt_pk_bf16(o1[0], o1[1]), cvt_pk_bf16(o1[2], o1[3])};
                        *(u32x2*)(KR + (size_t)row * 64 + 32 + jj0) = (u32x2){cvt_pk_bf16(o2[0], o2[1]), cvt_pk_bf16(o2[2], o2[3])};
                    } } }
    }
};
struct EpiQ {
    static constexpr bool PERM = true, FUSED = false, F16 = false;
    bf16* Qn; bf16* Qr; const int* pos; const float* stat;
    __device__ __forceinline__ void operator()(const Acc& acc, const Unit& u, int wr, int wc, int fr, int fq) const {
        const int row0 = u.pm * BM + wr * 64 + fr;
        if (u.pn < 4) {
            const int col = u.pn * BM + wc * 32 + 8 * fq;
#pragma unroll
            for (int ai = 0; ai < 2; ++ai)
#pragma unroll
                for (int m = 0; m < 4; ++m) { const int row = row0 + ai * HALF + m * 16; bf16* p = Qn + (size_t)row * DM + col;
                    const float sc = QSCALE / sqrtf(stat[(size_t)row * 2] * (1.f / QLR) + RMS_EPS);
#pragma unroll
                    for (int bj = 0; bj < 2; ++bj) *(u32x4*)(p + bj * HALF) = pack8(acc[ai][bj][m][0] * sc, acc[ai][bj][m][1] * sc); }
        } else {
            const int head = 4 * (u.pn - 4) + wc, j0 = 8 * fq;
#pragma unroll
            for (int ai = 0; ai < 2; ++ai)
#pragma unroll
                for (int m = 0; m < 4; ++m) {
                    const int row = row0 + ai * HALF + m * 16; const int ps = pos[row];
                    const float sc = QSCALE / sqrtf(stat[(size_t)row * 2] * (1.f / QLR) + RMS_EPS);
                    f32x4 o1[2], o2[2];
#pragma unroll
                    for (int n = 0; n < 2; ++n)
#pragma unroll
                        for (int e = 0; e < 4; ++e) { float c, s; rope_cs(ps, j0 + 4 * n + e, c, s); const float t1 = acc[ai][0][m][n][e], t2 = acc[ai][1][m][n][e];
                            o1[n][e] = (t1 * c - t2 * s) * sc; o2[n][e] = (t2 * c + t1 * s) * sc; }
                    bf16* p = Qr + (size_t)row * 512 + head * 64 + j0;
                    *(u32x4*)p = pack8(o1[0], o1[1]); *(u32x4*)(p + 32) = pack8(o2[0], o2[1]);
                }
        }
    }
};
struct EpiKV {
    static constexpr bool PERM = true, FUSED = false, F16 = false;
    bf16* Kn; bf16* V; const float* stat;
    __device__ __forceinline__ void operator()(const Acc& acc, const Unit& u, int wr, int wc, int fr, int fq) const {
        const int row0 = u.pm * BM + wr * 64 + fr, col = u.pn * 128 + wc * 32 + 8 * fq;
#pragma unroll
        for (int ai = 0; ai < 2; ++ai)
#pragma unroll
            for (int m = 0; m < 4; ++m) { const int row = row0 + ai * HALF + m * 16; const size_t off = (size_t)row * DM + col;
                const float sc = 1.0f / sqrtf(stat[(size_t)row * 2 + 1] * (1.f / KVLR) + RMS_EPS);
                *(u32x4*)(Kn + off) = pack8(acc[ai][0][m][0] * sc, acc[ai][0][m][1] * sc); *(u32x4*)(V + off) = pack8(acc[ai][1][m][0] * sc, acc[ai][1][m][1] * sc); }
    }
};
struct EpiLruIn {
    static constexpr bool PERM = true, FUSED = false, F16 = true;
    bf16* GG; bf16* XR;
    __device__ __forceinline__ void operator()(const Acc& acc, const Unit& u, int wr, int wc, int fr, int fq) const {
        const int row0 = u.pm * BM + wr * 64 + fr; const bool isg = u.pn < 4; const int col = (u.pn & 3) * BM + wc * 32 + 8 * fq; bf16* base = isg ? GG : XR;
#pragma unroll
        for (int ai = 0; ai < 2; ++ai)
#pragma unroll
            for (int m = 0; m < 4; ++m) { bf16* p = base + (size_t)(row0 + ai * HALF + m * 16) * DM + col;
#pragma unroll
                for (int bj = 0; bj < 2; ++bj) { f32x4 a = acc[ai][bj][m][0], b = acc[ai][bj][m][1];
                    if (isg) {
#pragma unroll
                        for (int e = 0; e < 4; ++e) { a[e] = gelu_tanh_f(a[e]); b[e] = gelu_tanh_f(b[e]); } }
                    *(u32x4*)(p + bj * HALF) = pack8(a, b); } }
    }
};
struct EpiGate {
    static constexpr bool PERM = true, FUSED = false, F16 = false;
    unsigned* P; const bf16* XC; const float* gate_b; const float* lam;
    __device__ __forceinline__ void operator()(const Acc& acc, const Unit& u, int wr, int wc, int fr, int fq) const {
        const int dir = u.pn >> 3, nb = (u.pn >> 1) & 3, hd = u.pn & 1;
        const int row0 = u.pm * BM + wr * 64 + fr, ch0 = nb * 256 + hd * 128 + wc * 32 + 8 * fq;
        float br[8], bi[8], ls[8];
#pragma unroll
        for (int e = 0; e < 8; ++e) { br[e] = gate_b[(2 * dir) * DM + ch0 + e]; bi[e] = gate_b[(2 * dir + 1) * DM + ch0 + e];
            ls[e] = lam[dir * DM + ch0 + e]; }
        unsigned* Pd = P + (size_t)dir * M * DM;
#pragma unroll
        for (int ai = 0; ai < 2; ++ai)
#pragma unroll
            for (int m = 0; m < 4; ++m) {
                const size_t off = (size_t)(row0 + ai * HALF + m * 16) * DM + ch0;
                const u32x4 xw = *(const u32x4*)(XC + off);
                unsigned w[8];
#pragma unroll
                for (int e = 0; e < 8; ++e) {
                    const float r = fast_sigmoid(acc[ai][0][m][e >> 2][e & 3] + br[e]), ig = fast_sigmoid(acc[ai][1][m][e >> 2][e & 3] + bi[e]);
                    const unsigned xww = xw[e >> 1]; const float xc = (e & 1) ? bf_hi(xww) : bf_lo(xww);
                    const float la2 = r * ls[e]; const float a2 = __builtin_amdgcn_exp2f(2.0f * la2);
                    const float uu = __builtin_amdgcn_sqrtf(fmaxf(1.0f - a2, 0.0f)) * ig * xc;
                    w[e] = cvt_pk_bf16(la2, uu);
                }
                *(u32x4*)(Pd + off) = (u32x4){w[0], w[1], w[2], w[3]}; *(u32x4*)(Pd + off + 4) = (u32x4){w[4], w[5], w[6], w[7]};
            }
    }
};

template <class Epi>
__device__ __forceinline__ void gemm_phase(LAS unsigned char* lds, const Gemm g, const StaticOrder& S, const Epi& E) {
    int tid_ = threadIdx.x; asm volatile("" : "+v"(tid_));
    const int tid = tid_, wid = __builtin_amdgcn_readfirstlane(tid >> 6), lane = tid & 63, wr = wid >> 2, wc = wid & 3, fr = lane & 15, fq = lane >> 4;
    int K_ = g.K; asm volatile("" : "+s"(K_));
    const int K = K_, nt = K / BK;
    unsigned voffA[2], voffB[2];
#pragma unroll
    for (int i = 0; i < 2; ++i) { int R, C; stage_rc(tid * 16 + i * 8192, R, C); const int Rb = Epi::PERM ? ((R & ~31) + perm32(R & 31)) : R;
        voffA[i] = (unsigned)(R * g.lda + C) * 2u; voffB[i] = (unsigned)(Rb * g.ldb + C) * 2u; }
    const size_t kstep = (size_t)(BK * 2);
    const size_t hstepA = (size_t)HALF * g.lda * 2, hstepB = (size_t)HALF * g.ldb * 2;
    const unsigned ldsw = (unsigned)wid * 1024u;
    const int aoff = lds_byte(wr * 64 + fr, fq * 8), boff = lds_byte(wc * 32 + fr, fq * 8);
#define PG8_UA(u) ((const char*)g.A + (size_t)(u).pm * 2 * hstepA + (size_t)((((u).pn >> g.a_sh) & g.a_mask) * g.a_cols) * 2)
#define PG8_UB(u) ((const char*)g.Bt + (size_t)(u).pn * 2 * hstepB)
#define PG8_SA(b, h) (((b) * 2 + (h)) * HTB)
#define PG8_SB(b, h) ((4 + (b) * 2 + (h)) * HTB)
#define PG8_STAGE(bufoff, gbase, voff) do { _Pragma("unroll") for (int _i = 0; _i < 2; ++_i) \
        __builtin_amdgcn_global_load_lds((const unsigned*)((const char*)(gbase) + (voff)[_i]), (LAS unsigned*)(lds + (bufoff) + ldsw + _i * 8192), 16, 0, 0); } while (0)
#define PG8_LDA(dst, b, h) do { _Pragma("unroll") for (int m = 0; m < 4; ++m) _Pragma("unroll") for (int k = 0; k < 2; ++k) dst[m][k] = *(const LAS bf16x8*)(lds + PG8_SA(b, h) + aoff + m * 2048 + k * 1024); } while (0)
#define PG8_LDB(dst, b, h) do { _Pragma("unroll") for (int n = 0; n < 2; ++n) _Pragma("unroll") for (int k = 0; k < 2; ++k) dst[n][k] = *(const LAS bf16x8*)(lds + PG8_SB(b, h) + boff + n * 2048 + k * 1024); } while (0)
#define PG8_MMA(ai, bj, At, Bt) do { __builtin_amdgcn_s_setprio(1); _Pragma("unroll") for (int m = 0; m < 4; ++m) _Pragma("unroll") for (int n = 0; n < 2; ++n) _Pragma("unroll") for (int k = 0; k < 2; ++k) \
        { if constexpr (Epi::F16) acc[ai][bj][m][n] = __builtin_amdgcn_mfma_f32_16x16x32_f16(__builtin_bit_cast(f16x8, Bt[n][k]), __builtin_bit_cast(f16x8, At[m][k]), acc[ai][bj][m][n], 0, 0, 0); \
          else acc[ai][bj][m][n] = __builtin_amdgcn_mfma_f32_16x16x32_bf16(Bt[n][k], At[m][k], acc[ai][bj][m][n], 0, 0, 0); } __builtin_amdgcn_s_setprio(0); } while (0)
#define PG8_WAIT_V(n) asm volatile("s_waitcnt vmcnt(" #n ")" ::: "memory")
#define PG8_WAIT_L(n) asm volatile("s_waitcnt lgkmcnt(" #n ")" ::: "memory")
#define PG8_BAR __builtin_amdgcn_s_barrier()
#define PG8_SCHED __builtin_amdgcn_sched_barrier(0)
    Unit cur, nxt; int ui = 0;
    if (!S.next(0, cur)) return;
    Acc acc;
#pragma unroll
    for (int a = 0; a < 2; ++a)
#pragma unroll
        for (int b = 0; b < 2; ++b)
#pragma unroll
            for (int m = 0; m < 4; ++m)
#pragma unroll
                for (int n = 0; n < 2; ++n) acc[a][b][m][n] = (f32x4){0.f, 0.f, 0.f, 0.f};
    bf16x8 At[4][2], B0[2][2], B1[2][2];
    const char* cA = PG8_UA(cur); const char* cB = PG8_UB(cur);
    PG8_STAGE(PG8_SB(0, 0), cB, voffB); PG8_STAGE(PG8_SB(0, 1), cB + hstepB, voffB); PG8_STAGE(PG8_SA(0, 0), cA, voffA); PG8_STAGE(PG8_SA(0, 1), cA + hstepA, voffA);
    PG8_STAGE(PG8_SB(1, 0), cB + kstep, voffB); PG8_STAGE(PG8_SA(1, 0), cA + kstep, voffA); PG8_STAGE(PG8_SB(1, 1), cB + hstepB + kstep, voffB);
    if (wr == 1) PG8_BAR;
    PG8_WAIT_V(8); PG8_BAR;
    PG8_WAIT_V(6); PG8_BAR;
    for (;;) {
        const bool has_next = S.next(ui + 1, nxt);
        const char* nA = has_next ? PG8_UA(nxt) : cA; const char* nB = has_next ? PG8_UB(nxt) : cB;
        for (int t = 0; t < nt; t += 2) {
            const bool last = (t == nt - 2);
            const char* a1 = cA + (size_t)(t + 1) * kstep;
            const char* a2 = last ? nA : cA + (size_t)(t + 2) * kstep; const char* b2 = last ? nB : cB + (size_t)(t + 2) * kstep;
            const char* a3 = a2 + kstep; const char* b3 = b2 + kstep;
            PG8_LDB(B0, 0, 0); PG8_LDB(B1, 0, 1); PG8_SCHED; PG8_LDA(At, 0, 0); PG8_STAGE(PG8_SA(1, 1), a1 + hstepA, voffA);
            PG8_WAIT_V(8); PG8_WAIT_L(0); PG8_BAR; PG8_MMA(0, 0, At, B0); PG8_MMA(0, 1, At, B1); PG8_BAR; PG8_SCHED;
            PG8_LDA(At, 0, 1); PG8_STAGE(PG8_SB(0, 0), b2, voffB); PG8_STAGE(PG8_SB(0, 1), b2 + hstepB, voffB); PG8_STAGE(PG8_SA(0, 0), a2, voffA);
            PG8_WAIT_V(8); PG8_WAIT_L(0); PG8_BAR; PG8_MMA(1, 0, At, B0); PG8_MMA(1, 1, At, B1); PG8_BAR; PG8_SCHED;
            PG8_LDB(B0, 1, 0); PG8_LDB(B1, 1, 1); PG8_SCHED; PG8_LDA(At, 1, 0); PG8_STAGE(PG8_SA(0, 1), a2 + hstepA, voffA);
            PG8_WAIT_V(8); PG8_WAIT_L(0); PG8_BAR; PG8_MMA(0, 0, At, B0); PG8_MMA(0, 1, At, B1); PG8_BAR; PG8_SCHED;
            PG8_LDA(At, 1, 1); PG8_STAGE(PG8_SB(1, 0), b3, voffB); PG8_STAGE(PG8_SB(1, 1), b3 + hstepB, voffB); PG8_STAGE(PG8_SA(1, 0), a3, voffA);
            PG8_WAIT_V(8); PG8_WAIT_L(0); PG8_BAR; PG8_MMA(1, 0, At, B0); PG8_MMA(1, 1, At, B1); PG8_BAR; PG8_SCHED;
        }
        if (wr == 0) PG8_BAR;
        if constexpr (Epi::FUSED) E.fused(acc, cur, wr, wc, fr, fq, lds + STAGE_BYTES, wid, lane); else E(acc, cur, wr, wc, fr, fq);
        if (!has_next) break;
#pragma unroll
        for (int a = 0; a < 2; ++a)
#pragma unroll
            for (int b = 0; b < 2; ++b)
#pragma unroll
                for (int m = 0; m < 4; ++m)
#pragma unroll
                    for (int n = 0; n < 2; ++n) acc[a][b][m][n] = (f32x4){0.f, 0.f, 0.f, 0.f};
        cur = nxt; cA = nA; cB = nB; ++ui;
        if (wr == 1) PG8_BAR;
    }
    PG8_WAIT_V(0);
    PG8_BAR;
#undef PG8_UA
#undef PG8_UB
#undef PG8_SA
#undef PG8_SB
#undef PG8_STAGE
#undef PG8_LDA
#undef PG8_LDB
#undef PG8_MMA
#undef PG8_WAIT_V
#undef PG8_WAIT_L
#undef PG8_BAR
#undef PG8_SCHED
}
}

namespace attn {
constexpr int NW = 8, QBLK = 32, KVBLK = 64, KROW = 400;
constexpr int SHM_V = KVBLK * 128 * 2, SHM_K = KVBLK * KROW, SHM_ATTN = 2 * SHM_V + 2 * SHM_K + NW * 64 * 4;
#define SBAR() __builtin_amdgcn_sched_barrier(0)
__device__ __forceinline__ int crow(int r, int hi) { return (r & 3) + 8 * (r >> 2) + 4 * hi; }
__device__ __forceinline__ void partialSM(f32x16& p0, f32x16& p1, float& m_reg, float& mn, float& alpha) {
    float pmax = p0[0];
#pragma unroll
    for (int r = 1; r < 16; ++r) pmax = fmaxf(pmax, p0[r]);
#pragma unroll
    for (int r = 0; r < 16; ++r) pmax = fmaxf(pmax, p1[r]);
    { auto rr = __builtin_amdgcn_permlane32_swap(__float_as_uint(pmax), __float_as_uint(pmax), false, false);
      pmax = fmaxf(__uint_as_float(rr[0]), __uint_as_float(rr[1])); }
    if (__builtin_expect(__all(pmax - m_reg <= THR2), 1)) { mn = m_reg; alpha = 1.f; }
    else { mn = fmaxf(m_reg, pmax); alpha = __builtin_amdgcn_exp2f(m_reg - mn); m_reg = mn; }
#pragma unroll
    for (int r = 0; r < 16; ++r) p0[r] = p0[r] - mn;
#pragma unroll
    for (int r = 0; r < 16; ++r) p1[r] = p1[r] - mn;
#pragma unroll
    for (int r = 0; r < 16; ++r) p0[r] = __builtin_amdgcn_exp2f(p0[r]);
}
__device__ __forceinline__ void sm_decide(float pmax, float& m_reg, float& mn, float& alpha) {
    { auto rr = __builtin_amdgcn_permlane32_swap(__float_as_uint(pmax), __float_as_uint(pmax), false, false);
      pmax = fmaxf(__uint_as_float(rr[0]), __uint_as_float(rr[1])); }
    if (__builtin_expect(__all(pmax - m_reg <= THR2), 1)) { mn = m_reg; alpha = 1.f; }
    else { mn = fmaxf(m_reg, pmax); alpha = __builtin_amdgcn_exp2f(m_reg - mn); m_reg = mn; }
}
__device__ __forceinline__ void sm_tail(f32x16& p0, f32x16& p1, float mn) {
#pragma unroll
    for (int r = 0; r < 16; ++r) p0[r] = p0[r] - mn;
#pragma unroll
    for (int r = 0; r < 16; ++r) p1[r] = p1[r] - mn;
#pragma unroll
    for (int r = 0; r < 16; ++r) p0[r] = __builtin_amdgcn_exp2f(p0[r]);
}
__device__ __forceinline__ void finishSM(f32x16& p0, f32x16& p1, float alpha, float& l_reg, bf16x8& pa0, bf16x8& pa1, bf16x8& pa2, bf16x8& pa3) {
#pragma unroll
    for (int r = 0; r < 16; ++r) p1[r] = __builtin_amdgcn_exp2f(p1[r]);
    float ps = 0;
#pragma unroll
    for (int r = 0; r < 16; ++r) ps += p0[r];
#pragma unroll
    for (int r = 0; r < 16; ++r) ps += p1[r];
    { auto rr = __builtin_amdgcn_permlane32_swap(__float_as_uint(ps), __float_as_uint(ps), false, false);
      ps = __uint_as_float(rr[0]) + __uint_as_float(rr[1]); }
    l_reg = l_reg * alpha + ps;
#define PK4(P, BASE, OUT) do { unsigned a0 = cvt_pk_bf16(P[BASE + 0], P[BASE + 1]), a1 = cvt_pk_bf16(P[BASE + 2], P[BASE + 3]);   \
    unsigned b0 = cvt_pk_bf16(P[BASE + 4], P[BASE + 5]), b1 = cvt_pk_bf16(P[BASE + 6], P[BASE + 7]);                              \
    auto r0 = __builtin_amdgcn_permlane32_swap(a0, b0, false, false); auto r1 = __builtin_amdgcn_permlane32_swap(a1, b1, false, false); \
    u32x4 w = {r0[0], r1[0], r0[1], r1[1]}; OUT = *reinterpret_cast<bf16x8*>(&w); } while (0)
    PK4(p0, 0, pa0); PK4(p0, 8, pa1); PK4(p1, 0, pa2); PK4(p1, 8, pa3);
#undef PK4
}
__device__ __forceinline__ void qkt(f32x16& p0, f32x16& p1, const char* Ks, const bf16x8* qr, int r32, int hi) {
    p0 = f32x16{}; p1 = f32x16{};
#pragma unroll
    for (int d0 = 0; d0 < 12; ++d0) { const int cb = (d0 * 16 + hi * 8) * 2;
        const bf16x8 b0 = *reinterpret_cast<const bf16x8*>(Ks + r32 * KROW + cb);
        const bf16x8 b1 = *reinterpret_cast<const bf16x8*>(Ks + (32 + r32) * KROW + cb);
        p0 = __builtin_amdgcn_mfma_f32_32x32x16_bf16(b0, qr[d0], p0, 0, 0, 0);
        p1 = __builtin_amdgcn_mfma_f32_32x32x16_bf16(b1, qr[d0], p1, 0, 0, 0); }
}
__device__ __forceinline__ int v_st(int k, int c) { const int kk = (k & ~0xC) | ((k & 4) << 1) | ((k & 8) >> 1); return ((kk >> 3) * 4 + (c >> 5)) * 512 + ((kk & 7) * 32 + (c & 31)) * 2; }
__device__ __forceinline__ int v_rd_base(int lane) { return ((lane & 3) << 3) | (((lane >> 2) & 3) << 6) | (((lane >> 4) & 1) << 5) | (((lane >> 5) & 1) << 8); }
constexpr int v_rd_off(int d0, int ks, int half) { return d0 * 512 + ks * 4096 + half * 2048; }
template <int OFF> __device__ __forceinline__ s16x4 tr_read(int vb) {
    s16x4 r; asm volatile("ds_read_b64_tr_b16 %0, %1 offset:%2" : "=&v"(r) : "v"(vb), "i"(OFF) : "memory"); return r;
}
template <int D0> __device__ __forceinline__ void pv_one(f32x16& od, int vb, bf16x8 pa0, bf16x8 pa1, bf16x8 pa2, bf16x8 pa3) {
    const s16x4 l0 = tr_read<v_rd_off(D0, 0, 0)>(vb), h0 = tr_read<v_rd_off(D0, 0, 1)>(vb), l1 = tr_read<v_rd_off(D0, 1, 0)>(vb), h1 = tr_read<v_rd_off(D0, 1, 1)>(vb);
    const s16x4 l2 = tr_read<v_rd_off(D0, 2, 0)>(vb), h2 = tr_read<v_rd_off(D0, 2, 1)>(vb), l3 = tr_read<v_rd_off(D0, 3, 0)>(vb), h3 = tr_read<v_rd_off(D0, 3, 1)>(vb);
    asm volatile("s_waitcnt lgkmcnt(0)" ::: "memory"); SBAR();
#define PK(L, H) (bf16x8){L[0], L[1], L[2], L[3], H[0], H[1], H[2], H[3]}
    od = __builtin_amdgcn_mfma_f32_32x32x16_bf16(pa0, PK(l0, h0), od, 0, 0, 0);
    od = __builtin_amdgcn_mfma_f32_32x32x16_bf16(pa1, PK(l1, h1), od, 0, 0, 0);
    od = __builtin_amdgcn_mfma_f32_32x32x16_bf16(pa2, PK(l2, h2), od, 0, 0, 0);
    od = __builtin_amdgcn_mfma_f32_32x32x16_bf16(pa3, PK(l3, h3), od, 0, 0, 0);
#undef PK
}
template <int D0> __device__ __forceinline__ void pv_one_sm(f32x16& od, int vb, bf16x8 pa0, bf16x8 pa1, bf16x8 pa2, bf16x8 pa3, const f32x16& q0, const f32x16& q1, float& pmax) {
    const s16x4 l0 = tr_read<v_rd_off(D0, 0, 0)>(vb), h0 = tr_read<v_rd_off(D0, 0, 1)>(vb), l1 = tr_read<v_rd_off(D0, 1, 0)>(vb), h1 = tr_read<v_rd_off(D0, 1, 1)>(vb);
    const s16x4 l2 = tr_read<v_rd_off(D0, 2, 0)>(vb), h2 = tr_read<v_rd_off(D0, 2, 1)>(vb), l3 = tr_read<v_rd_off(D0, 3, 0)>(vb), h3 = tr_read<v_rd_off(D0, 3, 1)>(vb);
    {   const f32x16& q = (D0 < 2) ? q0 : q1; constexpr int B = (D0 & 1) * 8;
        float m = (D0 == 0) ? q[0] : pmax;
#pragma unroll
        for (int r = (D0 == 0) ? 1 : 0; r < 8; ++r) m = fmaxf(m, q[B + r]);
        pmax = m; }
    asm volatile("s_waitcnt lgkmcnt(0)" ::: "memory"); SBAR();
#define PK(L, H) (bf16x8){L[0], L[1], L[2], L[3], H[0], H[1], H[2], H[3]}
    od = __builtin_amdgcn_mfma_f32_32x32x16_bf16(pa0, PK(l0, h0), od, 0, 0, 0);
    od = __builtin_amdgcn_mfma_f32_32x32x16_bf16(pa1, PK(l1, h1), od, 0, 0, 0);
    od = __builtin_amdgcn_mfma_f32_32x32x16_bf16(pa2, PK(l2, h2), od, 0, 0, 0);
    od = __builtin_amdgcn_mfma_f32_32x32x16_bf16(pa3, PK(l3, h3), od, 0, 0, 0);
#undef PK
}
__device__ __forceinline__ void pv_sm(f32x16* o, int vb, bf16x8 pa0, bf16x8 pa1, bf16x8 pa2, bf16x8 pa3, const f32x16& q0, const f32x16& q1, float& pmax) {
    pv_one_sm<0>(o[0], vb, pa0, pa1, pa2, pa3, q0, q1, pmax); pv_one_sm<1>(o[1], vb, pa0, pa1, pa2, pa3, q0, q1, pmax);
    pv_one_sm<2>(o[2], vb, pa0, pa1, pa2, pa3, q0, q1, pmax); pv_one_sm<3>(o[3], vb, pa0, pa1, pa2, pa3, q0, q1, pmax);
}
__device__ __forceinline__ void pv_d0(f32x16* o, int vb, bf16x8 pa0, bf16x8 pa1, bf16x8 pa2, bf16x8 pa3) {
    pv_one<0>(o[0], vb, pa0, pa1, pa2, pa3); pv_one<1>(o[1], vb, pa0, pa1, pa2, pa3); pv_one<2>(o[2], vb, pa0, pa1, pa2, pa3); pv_one<3>(o[3], vb, pa0, pa1, pa2, pa3);
}
__device__ __forceinline__ void attn_unit(long rowb, int h, int q0, const bf16* Qn, const bf16* Qr, const bf16* __restrict__ Kn, const bf16* __restrict__ Kr, const bf16* __restrict__ Vv, bf16* O, char* lds) {
    int tid_ = threadIdx.x; asm volatile("" : "+v"(tid_));
    const int tid = tid_, wid = tid >> 6, lane = tid & 63, r32 = lane & 31, hi = lane >> 5;
    char* V_lds = lds; char* K_lds = lds + 2 * SHM_V;
    float* ws = (float*)(lds + 2 * SHM_V + 2 * SHM_K) + wid * 64; float* li_l = ws; float* al_l = ws + 32;
    float m_reg = -1e30f, l_reg = 0; f32x16 o[4] = {}; bf16x8 qr[12];
    const long qrow = rowb + q0 + wid * QBLK + r32;
#pragma unroll
    for (int d0 = 0; d0 < 8; ++d0) qr[d0] = *reinterpret_cast<const bf16x8*>(Qn + qrow * DM + h * 128 + d0 * 16 + hi * 8);
#pragma unroll
    for (int d0 = 0; d0 < 4; ++d0) qr[8 + d0] = *reinterpret_cast<const bf16x8*>(Qr + qrow * 512 + h * 64 + d0 * 16 + hi * 8);
    const int sr = tid >> 4, sc = (tid & 15) * 8, vst0 = v_st(sr, sc), vst1 = v_st(32 + sr, sc);
    const int ksr = tid >> 3, ksub = tid & 7;
    const int vb0 = (int)(uintptr_t)V_lds + v_rd_base(lane);
    const bf16* Vh = Vv + rowb * DM + h * 128; const bf16* Knh = Kn + rowb * DM + h * 128; const bf16* Krh = Kr + rowb * 64;
    bf16x8 vs0, vs1, ks0, ks1, ks2;
#define SLOAD(k0) do { vs0 = *(const bf16x8*)(Vh + (long)((k0) + sr) * DM + sc); vs1 = *(const bf16x8*)(Vh + (long)((k0) + 32 + sr) * DM + sc); \
    ks0 = *(const bf16x8*)(Knh + (long)((k0) + ksr) * DM + ksub * 8); ks1 = *(const bf16x8*)(Knh + (long)((k0) + ksr) * DM + 64 + ksub * 8); \
    ks2 = *(const bf16x8*)(Krh + (long)((k0) + ksr) * 64 + ksub * 8); } while (0)
#define SWRITE(b) do { *(bf16x8*)(V_lds + (b) * SHM_V + vst0) = vs0; *(bf16x8*)(V_lds + (b) * SHM_V + vst1) = vs1; \
    *(bf16x8*)(K_lds + (b) * SHM_K + ksr * KROW + ksub * 16) = ks0; *(bf16x8*)(K_lds + (b) * SHM_K + ksr * KROW + 128 + ksub * 16) = ks1; \
    *(bf16x8*)(K_lds + (b) * SHM_K + ksr * KROW + 256 + ksub * 16) = ks2; } while (0)
#define SWAIT() asm volatile("s_waitcnt vmcnt(0)" ::: "memory")
#define RESC(a) do { if (__any((a) < 1.f)) { if (hi == 0) al_l[r32] = (a); asm volatile("s_waitcnt lgkmcnt(0)" ::: "memory"); \
    _Pragma("unroll") for (int d = 0; d < 4; ++d) _Pragma("unroll") for (int r = 0; r < 16; ++r) o[d][r] *= al_l[crow(r, hi)]; } } while (0)
    f32x16 pA0, pA1, pB0, pB1; float mnA, mnB, alA, alB; bf16x8 pa0, pa1, pa2, pa3; constexpr int NT = SEQ / KVBLK;
    float pmx;
    if (__builtin_amdgcn_readfirstlane(tid) >= 256) __builtin_amdgcn_s_setprio(1);
    SLOAD(0); SWAIT(); SWRITE(0); SLOAD(KVBLK); __syncthreads();
    qkt(pA0, pA1, K_lds, qr, r32, hi);
    { pmx = pA0[0];
#pragma unroll
      for (int r = 1; r < 16; ++r) pmx = fmaxf(pmx, pA0[r]);
#pragma unroll
      for (int r = 0; r < 16; ++r) pmx = fmaxf(pmx, pA1[r]);
      sm_decide(pmx, m_reg, mnA, alA); }
    SWAIT(); SWRITE(1); __syncthreads();
    for (int j = 1; j + 1 < NT; j += 2) {
        SBAR(); qkt(pB0, pB1, K_lds + SHM_K, qr, r32, hi);
        sm_tail(pA0, pA1, mnA); finishSM(pA0, pA1, alA, l_reg, pa0, pa1, pa2, pa3); SBAR();
        SLOAD((j + 1) * KVBLK); SBAR();
        pv_sm(o, vb0, pa0, pa1, pa2, pa3, pB0, pB1, pmx); sm_decide(pmx, m_reg, mnB, alB);
        __syncthreads(); SWAIT(); SWRITE(0);
        RESC(alB); __syncthreads();
        SBAR(); qkt(pA0, pA1, K_lds, qr, r32, hi);
        sm_tail(pB0, pB1, mnB); finishSM(pB0, pB1, alB, l_reg, pa0, pa1, pa2, pa3); SBAR();
        SLOAD((j + 2) * KVBLK); SBAR();
        pv_sm(o, vb0 + SHM_V, pa0, pa1, pa2, pa3, pA0, pA1, pmx); sm_decide(pmx, m_reg, mnA, alA);
        __syncthreads(); SWAIT(); SWRITE(1);
        RESC(alA); __syncthreads();
    }
    SBAR(); qkt(pB0, pB1, K_lds + SHM_K, qr, r32, hi);
    sm_tail(pA0, pA1, mnA); finishSM(pA0, pA1, alA, l_reg, pa0, pa1, pa2, pa3); SBAR();
    pv_sm(o, vb0, pa0, pa1, pa2, pa3, pB0, pB1, pmx); sm_decide(pmx, m_reg, mnB, alB);
    __syncthreads(); RESC(alB);
    sm_tail(pB0, pB1, mnB); finishSM(pB0, pB1, alB, l_reg, pa0, pa1, pa2, pa3); SBAR();
    pv_d0(o, vb0 + SHM_V, pa0, pa1, pa2, pa3);
    __builtin_amdgcn_s_setprio(0);
    if (hi == 0) li_l[r32] = l_reg; asm volatile("s_waitcnt lgkmcnt(0)" ::: "memory");
    float rli[16];
#pragma unroll
    for (int r = 0; r < 16; ++r) rli[r] = __builtin_amdgcn_rcpf(li_l[crow(r, hi)]);
    bf16* Ow = O + (rowb + q0 + wid * QBLK) * DM + h * 128;
#pragma unroll
    for (int r = 0; r < 16; ++r) { const int orow = crow(r, hi);
#pragma unroll
        for (int d0 = 0; d0 < 4; ++d0) { const unsigned w = cvt_pk_bf16(o[d0][r] * rli[r], 0.f); Ow[(long)orow * DM + d0 * 32 + r32] = (bf16)(w & 0xffffu); } }
    __syncthreads();
#undef SLOAD
#undef SWRITE
#undef SWAIT
#undef RESC
}
#undef SBAR
}

__device__ __forceinline__ int rowmap(int mode, int n0) {
    if (mode == 0) return n0;
    if (mode == 1) return ((n0 >> 7) << 8) + (n0 & 127);
    if (mode == 2) return ((n0 >> 7) << 8) + 128 + (n0 & 127);
    if (mode == 4) { if (n0 < 640) return n0; const int c = n0 - 640, n = c >> 5, jj = c & 31; return 640 + 32 * (jj >> 4) + 8 * ((jj >> 2) & 3) + 4 * n + (jj & 3); }
    const int h = n0 / 192, d = n0 - h * 192;
    if (d < 128) return h * 128 + d;
    const int jj = d - 128;
    return 1024 + 256 * (h >> 2) + 128 * (jj >> 5) + 32 * (h & 3) + (jj & 31);
}
__device__ __forceinline__ void cvt_job(const float* W, int K, int N, bf16* WT, int mode, LAS float* scr, int gw, int NGW, int lane, int rot, bool f16 = false, const float* kscale = nullptr) {
    asm volatile("" : "+v"(lane));
    const int nblk = N / 32, nitems = (K / 64) * nblk;
    int start = gw - (rot % NGW); if (start < 0) start += NGW;
    for (int it = start; it < nitems; it += NGW) {
        const int kb = it / nblk, nb = it % nblk, k0 = 64 * kb, n0 = 32 * nb;
#pragma unroll 8
        for (int i = 0; i < 32; ++i) { const int kk = 2 * i + (lane >> 5); float w = W[(size_t)(k0 + kk) * N + n0 + (lane & 31)]; if (kscale) w *= kscale[k0 + kk]; scr[kk * 33 + (lane & 31)] = w; }
        asm volatile("s_waitcnt lgkmcnt(0)" ::: "memory");
        const int c = lane & 7;
#pragma unroll
        for (int j = 0; j < 4; ++j) { const int n = (lane >> 3) + 8 * j; const LAS float* s = scr + (8 * c) * 33 + n;
            u32x4 o;
            if (f16) {
                unsigned t0 = cvt_pk_bf16(s[0 * 33], s[1 * 33]), t1 = cvt_pk_bf16(s[2 * 33], s[3 * 33]), t2 = cvt_pk_bf16(s[4 * 33], s[5 * 33]), t3 = cvt_pk_bf16(s[6 * 33], s[7 * 33]);
                o.x = pk_f16(bf_lo(t0), bf_hi(t0)); o.y = pk_f16(bf_lo(t1), bf_hi(t1)); o.z = pk_f16(bf_lo(t2), bf_hi(t2)); o.w = pk_f16(bf_lo(t3), bf_hi(t3)); }
            else { o.x = cvt_pk_bf16(s[0 * 33], s[1 * 33]); o.y = cvt_pk_bf16(s[2 * 33], s[3 * 33]); o.z = cvt_pk_bf16(s[4 * 33], s[5 * 33]); o.w = cvt_pk_bf16(s[6 * 33], s[7 * 33]); }
            *(u32x4*)(WT + (size_t)rowmap(mode, n0 + n) * K + k0 + 8 * c) = o; }
        asm volatile("s_waitcnt lgkmcnt(0)" ::: "memory");
    }
}

struct Args { const float* in[20]; float* out; unsigned char* ws; int ph_lo, ph_hi; };

__device__ __forceinline__ void convert_layer(const Args& a, int L, LAS float* scr, int gw, int NGW, int lane) {
    asm volatile("" : "+v"(lane));
    unsigned char* wb = a.ws + WS_W;
    int rot = 0;
    for (int ff = 0; ff < 2; ++ff) {
        const size_t wo = (size_t)(L * 2 + ff) * DM * DFF;
        bf16* w13t = (bf16*)(wb + ff * W_FFN); bf16* w2t = (bf16*)(wb + ff * W_FFN + W_W2T);
        cvt_job(a.in[4] + wo, DM, DFF, w13t, 1, scr, gw, NGW, lane, rot, true); rot += 1408;
        cvt_job(a.in[5] + wo, DM, DFF, w13t, 2, scr, gw, NGW, lane, rot, true); rot += 1408;
        cvt_job(a.in[6] + wo, DFF, DM, w2t, 0, scr, gw, NGW, lane, rot); rot += 1408;
    }
    const int k = L >> 1;
    unsigned char* wm = wb + W_MIX;
    if ((L & 1) == 0) {
        bf16* w_in_t = (bf16*)(wm + W_MLA_IN);
        cvt_job(a.in[7] + (size_t)k * DM * 704, DM, 704, w_in_t, 4, scr, gw, NGW, lane, rot, true); rot += 352;
        for (int i = gw * 64 + lane; i < 64 * DM / 8; i += NGW * 64) *(u32x4*)(w_in_t + (size_t)704 * DM + (size_t)i * 8) = (u32x4){0u, 0u, 0u, 0u};
        cvt_job(a.in[10] + (size_t)k * QLR * 1536, QLR, 1536, (bf16*)(wm + W_MLA_UQ), 3, scr, gw, NGW, lane, rot, false, a.in[8] + k * QLR); rot += 288;
        cvt_job(a.in[11] + (size_t)k * KVLR * 2048, KVLR, 2048, (bf16*)(wm + W_MLA_UKV), 0, scr, gw, NGW, lane, rot, false, a.in[9] + k * KVLR); rot += 256;
        cvt_job(a.in[12] + (size_t)k * DM * DM, DM, DM, (bf16*)(wm + W_MLA_O), 0, scr, gw, NGW, lane, rot);
    } else {
        cvt_job(a.in[13] + (size_t)k * DM * 2048, DM, 2048, (bf16*)(wm + W_LRU_IN), 0, scr, gw, NGW, lane, rot, true); rot += 1024;
        for (int gn = 0; gn < 16; ++gn) { const int gate = gn >> 2, n = gn & 3;
            cvt_job(a.in[16] + (size_t)((k * 4 + gate) * 4 + n) * 65536, 256, 256, (bf16*)(wm + W_LRU_GATE) + (size_t)(((gate >> 1) * 4 + n) * 2) * 65536, (gate & 1) ? 2 : 1, scr, gw, NGW, lane, rot); rot += 32; }
        cvt_job(a.in[19] + (size_t)k * DM * DM, DM, DM, (bf16*)(wm + W_LRU_OUT), 0, scr, gw, NGW, lane, rot);
    }
}

__device__ __forceinline__ void cast_rows(const float* X, bf16* XN, int gw, int NGW, int lane) {
    asm volatile("" : "+v"(lane));
    for (int m = gw; m < M; m += NGW) {
        const f32x4* xr = (const f32x4*)(X + (size_t)m * DM) + lane; u32x2* o = (u32x2*)(XN + (size_t)m * DM) + lane;
#pragma unroll
        for (int j = 0; j < 4; ++j) { const f32x4 v = xr[64 * j]; o[64 * j] = (u32x2){pk_f16(v[0], v[1]), pk_f16(v[2], v[3])}; }
    }
}
__device__ __forceinline__ void ln_pass(const float* X, float* XO, bf16* XN, const float* g, const float* bt, int gw, int NGW, int lane) {
    asm volatile("" : "+v"(lane));
    f32x4 gv[4], bv[4];
#pragma unroll
    for (int j = 0; j < 4; ++j) { gv[j] = ((const f32x4*)g)[lane + 64 * j]; bv[j] = ((const f32x4*)bt)[lane + 64 * j]; }
    for (int m = gw; m < M; m += NGW) {
        const f32x4* xr = (const f32x4*)(X + (size_t)m * DM) + lane; f32x4* xo = (f32x4*)(XO + (size_t)m * DM) + lane; u32x2* o = (u32x2*)(XN + (size_t)m * DM) + lane;
        f32x4 v[4]; float s = 0.f;
#pragma unroll
        for (int j = 0; j < 4; ++j) { v[j] = xr[64 * j]; s += (v[j][0] + v[j][1]) + (v[j][2] + v[j][3]); }
        const float mean = wave_sum(s) * (1.f / DM); float s2 = 0.f;
#pragma unroll
        for (int j = 0; j < 4; ++j) { v[j] = v[j] - mean; s2 += (v[j][0] * v[j][0] + v[j][1] * v[j][1]) + (v[j][2] * v[j][2] + v[j][3] * v[j][3]); }
        const float rstd = 1.0f / sqrtf(wave_sum(s2) * (1.f / DM) + LN_EPS);
#pragma unroll
        for (int j = 0; j < 4; ++j) { const f32x4 y = v[j] * rstd * gv[j] + bv[j]; xo[64 * j] = y; o[64 * j] = (u32x2){cvt_pk_bf16(y[0], y[1]), cvt_pk_bf16(y[2], y[3])}; }
    }
}
__device__ __forceinline__ void mla_norm_pass(const float* hm, bf16* cqn, bf16* ckvn, bf16* Kr, const float* qg, const float* kvg, const int* pos, int gw, int NGW, int lane) {
    asm volatile("" : "+v"(lane));
    for (int m = gw; m < M; m += NGW) {
        const float* r = hm + (size_t)m * 768;
        const f32x2 a0 = *(const f32x2*)(r + 6 * lane), a1 = *(const f32x2*)(r + 6 * lane + 2), a2 = *(const f32x2*)(r + 6 * lane + 4);
        const f32x4 kv = *(const f32x4*)(r + 384 + 4 * lane);
        const float kr = r[640 + lane];
        const float sq = wave_sum((a0[0] * a0[0] + a0[1] * a0[1]) + (a1[0] * a1[0] + a1[1] * a1[1]) + (a2[0] * a2[0] + a2[1] * a2[1]));
        const float skv = wave_sum((kv[0] * kv[0] + kv[1] * kv[1]) + (kv[2] * kv[2] + kv[3] * kv[3]));
        const float rq = 1.0f / sqrtf(sq * (1.f / QLR) + RMS_EPS), rkv = 1.0f / sqrtf(skv * (1.f / KVLR) + RMS_EPS);
        const f32x2 g0 = *(const f32x2*)(qg + 6 * lane), g1 = *(const f32x2*)(qg + 6 * lane + 2), g2 = *(const f32x2*)(qg + 6 * lane + 4);
        unsigned* oq = (unsigned*)(cqn + (size_t)m * QLR + 6 * lane);
        oq[0] = cvt_pk_bf16(a0[0] * rq * g0[0], a0[1] * rq * g0[1]); oq[1] = cvt_pk_bf16(a1[0] * rq * g1[0], a1[1] * rq * g1[1]); oq[2] = cvt_pk_bf16(a2[0] * rq * g2[0], a2[1] * rq * g2[1]);
        const f32x4 gk = *(const f32x4*)(kvg + 4 * lane);
        *(u32x2*)(ckvn + (size_t)m * KVLR + 4 * lane) = (u32x2){cvt_pk_bf16(kv[0] * rkv * gk[0], kv[1] * rkv * gk[1]), cvt_pk_bf16(kv[2] * rkv * gk[2], kv[3] * rkv * gk[3])};
        const float other = __shfl_xor(kr, 32);
        float c, s; rope_cs(pos[m], lane & 31, c, s);
        const float outv = (lane < 32) ? (kr * c - other * s) : (kr * c + other * s);
        Kr[(size_t)m * 64 + lane] = (bf16)(cvt_pk_bf16(outv, 0.f) & 0xffffu);
    }
}
__device__ __forceinline__ void conv_pass(const bf16* __restrict__ xr, bf16* __restrict__ xc, const float* __restrict__ cw, const float* __restrict__ cb, int gw, int NGW, int lane) {
    asm volatile("" : "+v"(lane));
    constexpr int RPW = 16;
    for (int blk = gw; blk < M / RPW; blk += NGW) {
        const int m0 = blk * RPW, t0 = m0 & (SEQ - 1);
#pragma unroll
        for (int half = 0; half < 2; ++half) {
            const int c0 = half * 512 + lane * 8;
            u32x4 rows[RPW + 3];
#pragma unroll
            for (int i = 0; i < RPW + 3; ++i) { const int tt = t0 + i - 2;
                rows[i] = (tt >= 0 && tt < SEQ) ? *(const u32x4*)(xr + (size_t)(m0 + i - 2) * DM + c0) : (u32x4){0u, 0u, 0u, 0u}; }
            f32x4 k0[4], k1[4];
#pragma unroll
            for (int j = 0; j < 4; ++j) { k0[j] = *(const f32x4*)(cw + j * DM + c0); k1[j] = *(const f32x4*)(cw + j * DM + c0 + 4); }
            const f32x4 b0 = *(const f32x4*)(cb + c0), b1 = *(const f32x4*)(cb + c0 + 4);
#pragma unroll
            for (int i = 0; i < RPW; ++i) {
                f32x4 a0 = b0, a1 = b1;
#pragma unroll
                for (int j = 0; j < 4; ++j) { const u32x4 w = rows[i + j];
                    a0[0] += k0[j][0] * bf_lo(w.x); a0[1] += k0[j][1] * bf_hi(w.x); a0[2] += k0[j][2] * bf_lo(w.y); a0[3] += k0[j][3] * bf_hi(w.y);
                    a1[0] += k1[j][0] * bf_lo(w.z); a1[1] += k1[j][1] * bf_hi(w.z); a1[2] += k1[j][2] * bf_lo(w.w); a1[3] += k1[j][3] * bf_hi(w.w); }
                *(u32x4*)(xc + (size_t)(m0 + i) * DM + c0) = (u32x4){cvt_pk_bf16(a0[0], a0[1]), cvt_pk_bf16(a0[2], a0[3]), cvt_pk_bf16(a1[0], a1[1]), cvt_pk_bf16(a1[2], a1[3])};
            }
        }
    }
}
constexpr int NCHUNK = 32, CLEN = SEQ / NCHUNK;
__device__ __forceinline__ void scan_pass1(const unsigned* P, f32x2* agg, int tid_in, int bx, int gthreads) {
    asm volatile("" : "+v"(tid_in)); const int gtid = bx * 512 + tid_in;
    f32x4* agg4 = (f32x4*)agg;
    for (int T = gtid; T < BATCH * NCHUNK * (DM / 2); T += gthreads) {
        const int chp = T & 511, chunk = (T >> 9) & (NCHUNK - 1), b = T >> 14;
        const size_t base = ((size_t)b * SEQ + (size_t)chunk * CLEN) * DM + 2 * chp;
        {   const u32x2* p = (const u32x2*)(P + base); float h0 = 0.f, s0 = 0.f, h1 = 0.f, s1 = 0.f;
            for (int t0 = 0; t0 < CLEN; t0 += 16) { u32x2 w[16];
#pragma unroll
                for (int i = 0; i < 16; ++i) w[i] = p[(size_t)(t0 + i) * (DM / 2)];
#pragma unroll
                for (int i = 0; i < 16; ++i) { const float la = bf_lo(w[i].x), lb = bf_lo(w[i].y); h0 = __builtin_amdgcn_exp2f(la) * h0 + bf_hi(w[i].x); s0 += la; h1 = __builtin_amdgcn_exp2f(lb) * h1 + bf_hi(w[i].y); s1 += lb; } }
            agg4[((size_t)(0 * BATCH + b) * NCHUNK + chunk) * (DM / 2) + chp] = (f32x4){s0, h0, s1, h1}; }
        {   const u32x2* p = (const u32x2*)(P + (size_t)M * DM + base); float h0 = 0.f, s0 = 0.f, h1 = 0.f, s1 = 0.f;
            for (int t0 = CLEN - 16; t0 >= 0; t0 -= 16) { u32x2 w[16];
#pragma unroll
                for (int i = 0; i < 16; ++i) w[i] = p[(size_t)(t0 + i) * (DM / 2)];
#pragma unroll
                for (int i = 15; i >= 0; --i) { const float la = bf_lo(w[i].x), lb = bf_lo(w[i].y); h0 = __builtin_amdgcn_exp2f(la) * h0 + bf_hi(w[i].x); s0 += la; h1 = __builtin_amdgcn_exp2f(lb) * h1 + bf_hi(w[i].y); s1 += lb; } }
            agg4[((size_t)(1 * BATCH + b) * NCHUNK + chunk) * (DM / 2) + chp] = (f32x4){s0, h0, s1, h1}; }
    }
}
__device__ __forceinline__ void scan_pass2(const unsigned* P, const f32x2* agg, bf16* HF, bf16* GG, int tid_in, int bx, int gthreads) {
    asm volatile("" : "+v"(tid_in)); const int gtid = bx * 512 + tid_in;
    const f32x4* agg4 = (const f32x4*)agg;
    for (int T = gtid; T < BATCH * NCHUNK * (DM / 2); T += gthreads) {
        const int chp = T & 511, chunk = (T >> 9) & (NCHUNK - 1), b = T >> 14;
        const size_t base = ((size_t)b * SEQ + (size_t)chunk * CLEN) * DM + 2 * chp;
        {   float h0 = 0.f, h1 = 0.f;
            const f32x4* ag = agg4 + ((size_t)(0 * BATCH + b) * NCHUNK) * (DM / 2) + chp;
            for (int c0 = 0; c0 < chunk; c0 += 8) { f32x4 ab[8];
#pragma unroll
                for (int i = 0; i < 8; ++i) ab[i] = ag[(size_t)(c0 + i) * (DM / 2)];
#pragma unroll
                for (int i = 0; i < 8; ++i) if (c0 + i < chunk) { h0 = __builtin_amdgcn_exp2f(ab[i][0]) * h0 + ab[i][1]; h1 = __builtin_amdgcn_exp2f(ab[i][2]) * h1 + ab[i][3]; } }
            const u32x2* p = (const u32x2*)(P + base); unsigned* hf = (unsigned*)(HF + base);
            u32x2 w[16], wn[16];
#pragma unroll
            for (int i = 0; i < 16; ++i) w[i] = p[(size_t)i * (DM / 2)];
            for (int t0 = 0; t0 < CLEN; t0 += 16) {
                if (t0 + 16 < CLEN) {
#pragma unroll
                    for (int i = 0; i < 16; ++i) wn[i] = p[(size_t)(t0 + 16 + i) * (DM / 2)]; }
#pragma unroll
                for (int i = 0; i < 16; ++i) { h0 = __builtin_amdgcn_exp2f(bf_lo(w[i].x)) * h0 + bf_hi(w[i].x); h1 = __builtin_amdgcn_exp2f(bf_lo(w[i].y)) * h1 + bf_hi(w[i].y);
                    hf[(size_t)(t0 + i) * (DM / 2)] = cvt_pk_bf16(h0, h1); }
#pragma unroll
                for (int i = 0; i < 16; ++i) w[i] = wn[i];
            } }
        __threadfence_block();
        {   float h0 = 0.f, h1 = 0.f;
            const f32x4* ag = agg4 + ((size_t)(1 * BATCH + b) * NCHUNK) * (DM / 2) + chp;
            for (int c0 = NCHUNK - 1; c0 > chunk; c0 -= 8) { f32x4 ab[8];
#pragma unroll
                for (int i = 0; i < 8; ++i) ab[i] = ag[(size_t)(c0 - i) * (DM / 2)];
#pragma unroll
                for (int i = 0; i < 8; ++i) if (c0 - i > chunk) { h0 = __builtin_amdgcn_exp2f(ab[i][0]) * h0 + ab[i][1]; h1 = __builtin_amdgcn_exp2f(ab[i][2]) * h1 + ab[i][3]; } }
            const u32x2* p = (const u32x2*)(P + (size_t)M * DM + base); const unsigned* hf = (const unsigned*)(HF + base); unsigned* gg = (unsigned*)(GG + base);
            u32x2 w[16], wn[16];
#pragma unroll
            for (int i = 0; i < 16; ++i) w[i] = p[(size_t)(CLEN - 16 + i) * (DM / 2)];
            for (int t0 = CLEN - 16; t0 >= 0; t0 -= 16) { unsigned f[16], g[16];
#pragma unroll
                for (int i = 0; i < 16; ++i) { f[i] = hf[(size_t)(t0 + i) * (DM / 2)]; g[i] = gg[(size_t)(t0 + i) * (DM / 2)]; }
                if (t0 >= 16) {
#pragma unroll
                    for (int i = 0; i < 16; ++i) wn[i] = p[(size_t)(t0 - 16 + i) * (DM / 2)]; }
#pragma unroll
                for (int i = 15; i >= 0; --i) { h0 = __builtin_amdgcn_exp2f(bf_lo(w[i].x)) * h0 + bf_hi(w[i].x); h1 = __builtin_amdgcn_exp2f(bf_lo(w[i].y)) * h1 + bf_hi(w[i].y);
                    gg[(size_t)(t0 + i) * (DM / 2)] = cvt_pk_bf16(bf_lo(g[i]) * (bf_lo(f[i]) + h0), bf_hi(g[i]) * (bf_hi(f[i]) + h1)); }
#pragma unroll
                for (int i = 0; i < 16; ++i) w[i] = wn[i]; } }
    }
}

#define XB_TMO      128
#define XB_XCNT(j)  (256  + 64 * (j))
#define XB_XSUB(j)  (1280 + 64 * (j))
#define XB_XGEN(j)  (2304 + 64 * (j))
#define XB_TOP      3328
#define XB_TOPGEN   3392
#define XCD_BAR_WORDS 3456
#define XB_SPIN_CAP (1u << 18)
__device__ __forceinline__ unsigned xb_ld(unsigned* p)              { return __hip_atomic_load(p, __ATOMIC_RELAXED, __HIP_MEMORY_SCOPE_AGENT); }
__device__ __forceinline__ unsigned xb_add(unsigned* p, unsigned v) { return __hip_atomic_fetch_add(p, v, __ATOMIC_RELAXED, __HIP_MEMORY_SCOPE_AGENT); }
__device__ __forceinline__ unsigned xb_xcc_id() { return (unsigned)__builtin_amdgcn_s_getreg((3 << 11) | 20) & 0xFu; }
#define XB_SPIN(cond, bar) do { unsigned _sp = 0; while (cond) { __builtin_amdgcn_s_sleep(1); \
    if ((++_sp & 255u) == 0u) { if (xb_ld(&(bar)[XB_TMO])) break; if (_sp > XB_SPIN_CAP) { atomicAdd(&(bar)[XB_TMO], 1u); break; } } } } while (0)
struct XcdBarrier { unsigned* bar; unsigned x; volatile LAS unsigned* st; };
__device__ __forceinline__ XcdBarrier xcd_barrier_post(unsigned* bar, volatile LAS unsigned* st) {
    XcdBarrier b; b.bar = bar; b.x = xb_xcc_id(); b.st = st;
    if (threadIdx.x == 0) (void)xb_add(&bar[XB_XCNT(b.x)], 1u);
    return b;
}
__device__ __forceinline__ void xcd_barrier_complete(unsigned* bar, unsigned x, unsigned& nloc, unsigned& nx) {
    const unsigned G = gridDim.x * gridDim.y * gridDim.z;
    unsigned sum, cnt, mine, sp = 0u;
    for (;;) {
        sum = 0u; cnt = 0u; mine = 0u;
#pragma unroll
        for (unsigned j = 0; j < 16; ++j) { const unsigned c = xb_ld(&bar[XB_XCNT(j)]); sum += c; cnt += (c > 0u) ? 1u : 0u; mine = (j == x) ? c : mine; }
        if (sum == G) break;
        __builtin_amdgcn_s_sleep(1);
        if ((++sp & 255u) == 0u) { if (xb_ld(&bar[XB_TMO])) break; if (sp > XB_SPIN_CAP) { atomicAdd(&bar[XB_TMO], 1u); break; } }
    }
    nloc = mine > 0u ? mine : 1u; nx = cnt > 0u ? cnt : 1u;
}
__device__ __forceinline__ void xcd_barrier(const XcdBarrier& b) {
    asm volatile("s_waitcnt vmcnt(0)" ::: "memory");
    __syncthreads();
    if (threadIdx.x == 0) {
        unsigned* bar = b.bar;
        __builtin_amdgcn_s_waitcnt(0);
        unsigned nloc = b.st[0], nx = b.st[1];
        if (nloc == 0u) { xcd_barrier_complete(bar, b.x, nloc, nx); b.st[0] = nloc; b.st[1] = nx; }
        const unsigned old = xb_add(&bar[XB_XSUB(b.x)], 1u);
        const unsigned gen = old / nloc;
        if (old + 1u == (gen + 1u) * nloc) {
            __builtin_amdgcn_fence(__ATOMIC_RELEASE, "agent");
            asm volatile("s_waitcnt vmcnt(0)" ::: "memory");
            const unsigned og = xb_add(&bar[XB_TOP], 1u);
            const unsigned tg = og / nx;
            if (og + 1u == (tg + 1u) * nx) xb_add(&bar[XB_TOPGEN], 1u);
            else XB_SPIN(xb_ld(&bar[XB_TOPGEN]) == tg, bar);
            __builtin_amdgcn_fence(__ATOMIC_ACQUIRE, "agent");
            xb_add(&bar[XB_XGEN(b.x)], 1u);
            asm volatile("s_waitcnt vmcnt(0)" ::: "memory");
        } else {
            XB_SPIN(xb_ld(&bar[XB_XGEN(b.x)]) == gen, bar);
            __builtin_amdgcn_fence(__ATOMIC_ACQUIRE, "agent");
            asm volatile("s_waitcnt vmcnt(0)" ::: "memory");
        }
    }
    __syncthreads();
}

constexpr int LDS_BYTES = 147456;
static_assert(attn::SHM_ATTN <= pg8::STAGE_BYTES, "attention LDS fits the stage region");

__global__ void __launch_bounds__(512, 2) fwd_megakernel(Args a) {
    extern __shared__ __attribute__((aligned(16))) unsigned char lds[];
    cg::grid_group grid = cg::this_grid();
    const int tid = threadIdx.x, lane = tid & 63, wave = __builtin_amdgcn_readfirstlane(tid >> 6);
    const int G = gridDim.x, bx = blockIdx.x;
    const int gw = bx * 8 + wave, NGW = G * 8;
    const int vcu = (G % 8 == 0) ? (bx % 8) * (G / 8) + bx / 8 : bx;
    LAS unsigned char* ldsl = (LAS unsigned char*)lds;
    LAS float* scr = (LAS float*)(ldsl + wave * 16384);
    unsigned char* ws = a.ws;
    const float* x_in = a.in[0]; const int* pos = (const int*)a.in[1];
    float* xbuf = a.out;
    bf16* xn = (bf16*)(ws + WS_R0);
    unsigned char* T = ws + WS_T;
    unsigned char* wb = ws + WS_W;
    int ph = 0;
    volatile LAS unsigned* bst = (volatile LAS unsigned*)(ldsl + 131072 + 12288);
    if (tid < 2) bst[tid] = 0u;
    __syncthreads();
    XcdBarrier bar = xcd_barrier_post((unsigned*)ws + 1024, bst);
    int nsync = 0;
    unsigned long long* xslots = (unsigned long long*)(ws + 42 * MiB);
#ifndef ONLY
#define ONLY -1
#endif
#define EN(k) (ONLY < 0 || ONLY == (k))
#define RUN(p) (a.ph_lo <= (p) && (p) < a.ph_hi)
#define SEAM() do { if (RUN(ph) && RUN(ph + 1)) { if (nsync == 0) grid.sync(); else { xcd_barrier(bar); } ++nsync; } ++ph; } while (0)

    if (EN(0) && RUN(ph)) { { int tl = tid; asm volatile("" : "+v"(tl)); for (int i = bx * 512 + tl; i < 2 * M * 2; i += G * 512) ((float*)(ws + 43 * MiB))[i] = 0.f; }
        convert_layer(a, 0, scr, gw, NGW, lane); cast_rows(x_in, xn, gw, NGW, lane); }
    SEAM();

#pragma nounroll
    for (int s = 0; s < 3 * DEPTH; ++s) {
        const int L = s / 3, j = s - 3 * L;
        if (j != 1) {
            const int ff = j >> 1;
            bf16* hbuf = (bf16*)(T + T_H);
            if (EN(1) && RUN(ph)) {
                pg8::Gemm g{xn, (const bf16*)(wb + ff * W_FFN), DM, DM, DM, 0, 0, 0}; pg8::StaticOrder S; S.init(M, 2 * DFF, G, bx);
                pg8::EpiSwiglu E{hbuf, DFF};
                pg8::gemm_phase<pg8::EpiSwiglu>(ldsl, g, S, E);
            }
            SEAM();
            if (EN(2) && RUN(ph)) {
                pg8::Gemm g{hbuf, (const bf16*)(wb + ff * W_FFN + W_W2T), DFF, DFF, DFF, 0, 0, 0}; pg8::StaticOrder S; S.init(M, DM, G, bx);
                pg8::EpiResid E{xn, xbuf, (s == 3 * DEPTH - 1) ? 1 : 0, ALPHA, 0.5f, a.in[2] + (size_t)s * DM, a.in[3] + (size_t)s * DM, xslots, 16u + (unsigned)s, (unsigned*)ws + 16};
                pg8::gemm_phase<pg8::EpiResid>(ldsl, g, S, E);
            }
            SEAM();
        } else if ((L & 1) == 0) {
            const int k = L >> 1;
            unsigned char* wm = wb + W_MIX;
            float* mstat = (float*)(ws + 43 * MiB) + (size_t)k * M * 2;
            bf16* Qn = (bf16*)(T + T_QN); bf16* Qr = (bf16*)(T + T_QR); bf16* cqn = (bf16*)(T + T_CQN); bf16* ckvn = (bf16*)(T + T_CKVN);
            bf16* Kn = (bf16*)(T + T_KN); bf16* Kr = (bf16*)(T + T_KR); bf16* Vb = (bf16*)(T + T_V);
            if (EN(3) && RUN(ph)) {
                pg8::Gemm g{xn, (const bf16*)(wm + W_MLA_IN), DM, DM, DM, 0, 0, 0}; pg8::StaticOrder S; S.init(M, 768, G, bx);
                pg8::EpiMlaIn E{cqn, ckvn, Kr, mstat, pos};
                pg8::gemm_phase<pg8::EpiMlaIn>(ldsl, g, S, E);
            }
            SEAM();
            if (RUN(ph)) {
                if (EN(5)) { pg8::Gemm g{cqn, (const bf16*)(wm + W_MLA_UQ), QLR, QLR, QLR, 0, 0, 0}; pg8::StaticOrder S; S.init(M, 1536, G, bx);
                  pg8::EpiQ E{Qn, Qr, pos, mstat};
                  pg8::gemm_phase<pg8::EpiQ>(ldsl, g, S, E); }
                if (EN(6)) { pg8::Gemm g{ckvn, (const bf16*)(wm + W_MLA_UKV), KVLR, KVLR, KVLR, 0, 0, 0}; pg8::StaticOrder S; S.init(M, 2048, G, bx);
                  pg8::EpiKV E{Kn, Vb, mstat};
                  pg8::gemm_phase<pg8::EpiKV>(ldsl, g, S, E); }
            }
            SEAM();
            if (EN(7) && RUN(ph)) {
                for (int U = vcu; U < BATCH * HEADS * (SEQ / 256); U += G) {
                    const int bh = U >> 4, qb = U & 15, b = bh >> 3, h = bh & 7;
                    attn::attn_unit((long)b * SEQ, h, qb * 256, Qn, Qr, Kn, Kr, Vb, Qn, (char*)lds);
                }
            }
            SEAM();
            if (EN(8) && RUN(ph)) {
                pg8::Gemm g{Qn, (const bf16*)(wm + W_MLA_O), DM, DM, DM, 0, 0, 0}; pg8::StaticOrder S; S.init(M, DM, G, bx);
                pg8::EpiResid E{xn, xbuf, 0, ALPHA, 1.0f, a.in[2] + (size_t)s * DM, a.in[3] + (size_t)s * DM, xslots, 16u + (unsigned)s, (unsigned*)ws + 16};
                pg8::gemm_phase<pg8::EpiResid>(ldsl, g, S, E);
            }
            SEAM();
        } else {
            const int k = L >> 1;
            unsigned char* wm = wb + W_MIX;
            bf16* gg = (bf16*)(T + T_GG); bf16* xr = (bf16*)(T + T_XR); unsigned* P = (unsigned*)(T + T_P); f32x2* agg = (f32x2*)(T + T_AGG);
            bf16* xc = (bf16*)xbuf;
            if (EN(9) && RUN(ph)) {
                pg8::Gemm g{xn, (const bf16*)(wm + W_LRU_IN), DM, DM, DM, 0, 0, 0}; pg8::StaticOrder S; S.init(M, 2048, G, bx);
                pg8::EpiLruIn E{gg, xr};
                pg8::gemm_phase<pg8::EpiLruIn>(ldsl, g, S, E);
            }
            SEAM();
            float* lstab = (float*)(T + T_AGG + 4 * MiB);
            if (EN(10) && RUN(ph) && bx == 0) { const float* lm = a.in[18] + (size_t)k * 2 * DM; int tl = tid; asm volatile("" : "+v"(tl)); for (int i = tl; i < 2 * DM; i += 512) lstab[i] = -8.0f * LOG2E * logf(1.0f + expf(-lm[i])); }
            if (EN(10) && RUN(ph)) conv_pass(xr, xc, a.in[14] + (size_t)k * 4 * DM, a.in[15] + (size_t)k * DM, gw, NGW, lane);
            SEAM();
            if (EN(11) && RUN(ph)) {
                pg8::Gemm g{xc, (const bf16*)(wm + W_LRU_GATE), DM, 256, 256, 1, 3, 256}; pg8::StaticOrder S; S.init(M, 4096, G, bx);
                pg8::EpiGate E{P, xc, a.in[17] + (size_t)k * 4 * DM, lstab};
                pg8::gemm_phase<pg8::EpiGate>(ldsl, g, S, E);
            }
            SEAM();
            if (EN(12) && RUN(ph)) scan_pass1(P, agg, tid, bx, G * 512);
            SEAM();
            if (EN(13) && RUN(ph)) scan_pass2(P, agg, xc, gg, tid, bx, G * 512);
            SEAM();
            if (EN(14) && RUN(ph)) {
                pg8::Gemm g{gg, (const bf16*)(wm + W_LRU_OUT), DM, DM, DM, 0, 0, 0}; pg8::StaticOrder S; S.init(M, DM, G, bx);
                pg8::EpiResid E{xn, xbuf, 0, ALPHA, 1.0f, a.in[2] + (size_t)s * DM, a.in[3] + (size_t)s * DM, xslots, 16u + (unsigned)s, (unsigned*)ws + 16};
                pg8::gemm_phase<pg8::EpiResid>(ldsl, g, S, E);
            }
            SEAM();
        }
        if (j == 2 && L + 1 < DEPTH) {
            if (EN(15) && RUN(ph)) convert_layer(a, L + 1, scr, gw, NGW, lane);
            SEAM();
        }
    }
#undef RUN
#undef SEAM
}

extern "C" void kernel_launch(void* const* d_in, const int* in_sizes, int n_in, void* d_out, int out_size, void* d_ws, size_t ws_size, hipStream_t stream) {
    static int grid = 0;
    if (grid == 0) {
        if (n_in != 20 || in_sizes[0] != M * DM || out_size != M * DM || ws_size < WS_END) {
            fprintf(stderr, "kernel_launch: unexpected shapes (n_in %d, in0 %d, out %d, ws %zu need %zu)\n", n_in, n_in > 0 ? in_sizes[0] : -1, out_size, ws_size, (size_t)WS_END); grid = -1; return; }
        int dev = 0, cus = 0, per_cu = 0;
        hipGetDevice(&dev); hipDeviceGetAttribute(&cus, hipDeviceAttributeMultiprocessorCount, dev);
        if (hipFuncSetAttribute((const void*)fwd_megakernel, hipFuncAttributeMaxDynamicSharedMemorySize, LDS_BYTES) != hipSuccess) { fprintf(stderr, "kernel_launch: hipFuncSetAttribute failed\n"); grid = -1; return; }
        if (hipOccupancyMaxActiveBlocksPerMultiprocessor(&per_cu, (const void*)fwd_megakernel, 512, LDS_BYTES) != hipSuccess || per_cu < 1) { fprintf(stderr, "kernel_launch: occupancy query gives %d\n", per_cu); per_cu = 1; }
        (void)hipGetLastError();
        grid = cus;
    }
    if (grid < 0) return;
    if (hipMemsetAsync(d_ws, 0, 65536, stream) != hipSuccess) { fprintf(stderr, "kernel_launch: memset failed\n"); return; }
    Args a{};
    for (int i = 0; i < 20; ++i) a.in[i] = (const float*)d_in[i];
    a.out = (float*)d_out; a.ws = (unsigned char*)d_ws;
#if MK_PER_PHASE
    for (int p = 0; p < N_PHASES; ++p) { a.ph_lo = p; a.ph_hi = p + 1; hipLaunchKernelGGL(fwd_megakernel, dim3(grid), dim3(512), LDS_BYTES, stream, a); }
#else
    a.ph_lo = 0; a.ph_hi = 1 << 20;
    void* args[] = {&a};
    hipError_t e = hipLaunchCooperativeKernel((const void*)fwd_megakernel, dim3(grid), dim3(512), args, LDS_BYTES, stream);
    if (e != hipSuccess) fprintf(stderr, "kernel_launch: cooperative launch failed: %s (grid %d)\n", hipGetErrorString(e), grid);
#endif
}
```
